# Optimizing an MI355X kernel written in HIP

```python
import math
import jax, jax.numpy as jnp
from jax import lax
import numpy as np

D_MODEL = 1024
BATCH = 2
SEQ = 16384
DEPTH = 2

CTX_LEN = 256
GRID_W = 64
DA_HEADS = 4
DA_HEAD_DIM = 64
DA_V_DIM = 2 * DA_HEAD_DIM
DA_WIDTH = DA_HEADS * DA_V_DIM
SSD_HEADS = 8
SSD_HEAD_DIM = 64
SSD_WIDTH = SSD_HEADS * SSD_HEAD_DIM
SSD_GROUPS = 2
SSD_STATE = 128
SSD_CONV = 5
SSD_CHUNK = 128
SSD_CONV_CH = SSD_WIDTH + 2 * SSD_GROUPS * SSD_STATE
D_MIX = DA_WIDTH + SSD_WIDTH
D_FF = ((8 * D_MODEL + 3 * 256 - 1) // (3 * 256)) * 256
Q_BLOCK = 128
ROPE_BASE = 10000.0
EPS = 1e-6
N_MOD = 6
QK_COLS = DA_HEADS * 2 * DA_HEAD_DIM
Q_END = QK_COLS
K_END = Q_END + QK_COLS
V_END = K_END + DA_WIDTH
Z_END = V_END + SSD_WIDTH
XBC_END = Z_END + SSD_CONV_CH
IN_COLS = XBC_END + 2 * SSD_HEADS

kernel_name = "hymba_diffattn_ssd_prefix_dit"


def rmsnorm(u, g):
    uf = u.astype(jnp.float32)
    y = uf * lax.rsqrt(jnp.mean(uf * uf, axis=-1, keepdims=True) + EPS)
    return (y * g.astype(jnp.float32)).astype(u.dtype)


def modulate(u, shift, scale):
    return u * (1 + scale) + shift


def axial_rope_tables(L):
    rows = L // GRID_W
    row = jnp.repeat(jnp.arange(rows, dtype=jnp.float32), GRID_W)
    col = jnp.tile(jnp.arange(GRID_W, dtype=jnp.float32), rows)
    nf = DA_HEAD_DIM // 4
    inv = ROPE_BASE ** (-jnp.arange(nf, dtype=jnp.float32) / nf)
    ang = jnp.concatenate([row[:, None] * inv, col[:, None] * inv], axis=-1)
    return jnp.cos(ang), jnp.sin(ang)


def apply_rope(u, cos, sin):
    u1, u2 = jnp.split(u, 2, axis=-1)
    c = cos[None, :, None, None, :].astype(u.dtype)
    s = sin[None, :, None, None, :].astype(u.dtype)
    return jnp.concatenate([u1 * c - u2 * s, u1 * s + u2 * c], axis=-1)


def dwconv_centred(u, w, b):
    ch = u.shape[-1]
    out = lax.conv_general_dilated(
        u, w[:, None, :].astype(u.dtype), window_strides=(1,),
        padding=[(SSD_CONV // 2, SSD_CONV // 2)],
        dimension_numbers=('NWC', 'WIO', 'NWC'), feature_group_count=ch)
    return jax.nn.silu(out + b)


def diff_attn_block(q, k, v, lam):
    s = jnp.einsum('bqhmd,bkhmd->bhmqk', q, k).astype(jnp.float32) * (DA_HEAD_DIM ** -0.5)
    p = jax.nn.softmax(s, axis=-1)
    pd = p[:, :, 0] - lam * p[:, :, 1]
    return jnp.einsum('bhqk,bkhe->bqhe', pd.astype(v.dtype), v)


def diff_attn_latent(q, k_all, v_all, lam):
    bsz, L, H, _, d = q.shape
    nb = L // Q_BLOCK
    qb = jnp.moveaxis(q.reshape(bsz, nb, Q_BLOCK, H, 2, d), 1, 0)
    o = lax.map(lambda qi: diff_attn_block(qi, k_all, v_all, lam), qb)
    return jnp.moveaxis(o, 0, 1).reshape(bsz, L, H, DA_V_DIM)


def ssd_scan(x, dt, A, Bm, Cm, h0):
    bsz, L, H, P = x.shape
    G, N = Bm.shape[2], Bm.shape[3]
    R = H // G
    nc = L // SSD_CHUNK

    def chunks(a):
        return jnp.moveaxis(a.reshape(bsz, nc, SSD_CHUNK, *a.shape[2:]), 1, 0)

    xs = chunks(x.astype(jnp.float32).reshape(bsz, L, G, R, P))
    dts = chunks(dt.reshape(bsz, L, G, R))
    bs = chunks(Bm.astype(jnp.float32))
    cs = chunks(Cm.astype(jnp.float32))
    a_g = A.reshape(G, R)
    lower = jnp.tril(jnp.ones((SSD_CHUNK, SSD_CHUNK), dtype=bool))[None, :, :, None, None]

    def step(h, inp):
        xc, dtc, bc, cc = inp
        cum = jnp.cumsum(dtc * a_g, axis=1)
        seg = cum[:, :, None] - cum[:, None, :]
        lmat = jnp.exp(jnp.where(lower, seg, -jnp.inf))
        xdt = xc * dtc[..., None]
        cb = jnp.einsum('bign,bjgn->bijg', cc, bc)
        y_diag = jnp.einsum('bijg,bijgr,bjgrp->bigrp', cb, lmat, xdt)
        y_off = jnp.einsum('bign,bgrpn,bigr->bigrp', cc, h, jnp.exp(cum))
        decay_end = jnp.exp(cum[:, -1:] - cum)
        h_new = h * jnp.exp(cum[:, -1])[..., None, None] + jnp.einsum(
            'bjgn,bjgr,bjgrp->bgrpn', bc, decay_end, xdt)
        return h_new, y_diag + y_off

    h_fin, ys = lax.scan(step, h0, (xs, dts, bs, cs))
    y = jnp.moveaxis(ys, 0, 1).reshape(bsz, L, H, P)
    return y, h_fin


def ssd_inputs(xbc, dtr, dt_bias):
    bsz, L, _ = xbc.shape
    gn = SSD_GROUPS * SSD_STATE
    xs = xbc[..., :SSD_WIDTH].reshape(bsz, L, SSD_HEADS, SSD_HEAD_DIM)
    bm = xbc[..., SSD_WIDTH:SSD_WIDTH + gn].reshape(bsz, L, SSD_GROUPS, SSD_STATE)
    cm = xbc[..., SSD_WIDTH + gn:].reshape(bsz, L, SSD_GROUPS, SSD_STATE)
    dt = jax.nn.softplus(dtr.astype(jnp.float32).reshape(bsz, L, 2, SSD_HEADS)
                         + dt_bias.astype(jnp.float32))
    return xs, bm, cm, dt


def gated_out_norm(y, z, g):
    bsz, L = z.shape[0], z.shape[1]
    u = y.reshape(bsz, L, SSD_WIDTH) * jax.nn.silu(z.astype(jnp.float32))
    return rmsnorm(u, g).astype(z.dtype)


def hybrid_mixer(h_l, h_c, w_in, conv_w, conv_b, a_log, dt_bias, d_skip, ssd_g,
                 lam_vec, sub_g, w_out, lam_init, cos, sin, need_ctx):
    p_l = h_l @ w_in
    p_c = h_c @ w_in
    bsz, L, _ = p_l.shape
    Lc = p_c.shape[1]

    def qkv(p, n):
        q = p[..., :Q_END].reshape(bsz, n, DA_HEADS, 2, DA_HEAD_DIM)
        k = p[..., Q_END:K_END].reshape(bsz, n, DA_HEADS, 2, DA_HEAD_DIM)
        v = p[..., K_END:V_END].reshape(bsz, n, DA_HEADS, DA_V_DIM)
        return q, k, v

    q_l, k_l, v_l = qkv(p_l, L)
    q_c, k_c, v_c = qkv(p_c, Lc)
    q_l = apply_rope(q_l, cos, sin)
    k_l = apply_rope(k_l, cos, sin)
    lv = lam_vec.astype(jnp.float32)
    lam = jnp.exp(jnp.sum(lv[0] * lv[1])) - jnp.exp(jnp.sum(lv[2] * lv[3])) + lam_init
    k_all = jnp.concatenate([k_c, k_l], axis=1)
    v_all = jnp.concatenate([v_c, v_l], axis=1)
    o_l = diff_attn_latent(q_l, k_all, v_all, lam)
    attn_l = (rmsnorm(o_l, sub_g) * (1.0 - lam_init)).reshape(bsz, L, DA_WIDTH)

    z_l, z_c = p_l[..., V_END:Z_END], p_c[..., V_END:Z_END]
    xbc_l = dwconv_centred(p_l[..., Z_END:XBC_END], conv_w, conv_b)
    xbc_c = dwconv_centred(p_c[..., Z_END:XBC_END], conv_w, conv_b)
    xl, bl, cl, dtl = ssd_inputs(xbc_l, p_l[..., XBC_END:], dt_bias)
    xc, bc, cc, dtc = ssd_inputs(xbc_c, p_c[..., XBC_END:], dt_bias)
    A = -jnp.exp(a_log.astype(jnp.float32))
    dsk = d_skip.astype(jnp.float32)[:, None]
    h0 = jnp.zeros((bsz, SSD_GROUPS, SSD_HEADS // SSD_GROUPS, SSD_HEAD_DIM, SSD_STATE),
                   jnp.float32)
    flip = lambda a: jnp.flip(a, axis=1)
    y_cf, h_cf = ssd_scan(xc, dtc[:, :, 0], A[0], bc, cc, h0)
    y_lf, _ = ssd_scan(xl, dtl[:, :, 0], A[0], bl, cl, h_cf)
    y_cb, h_cb = ssd_scan(flip(xc), flip(dtc[:, :, 1]), A[1], flip(bc), flip(cc), h0)
    y_lb, _ = ssd_scan(flip(xl), flip(dtl[:, :, 1]), A[1], flip(bl), flip(cl), h_cb)
    y_l = y_lf + flip(y_lb) + dsk * xl.astype(jnp.float32)
    ssd_l = gated_out_norm(y_l, z_l, ssd_g)

    mix_l = jnp.concatenate([attn_l, ssd_l], axis=-1) @ w_out
    if not need_ctx:
        return mix_l, None
    o_c = diff_attn_block(q_c, k_c, v_c, lam)
    attn_c = (rmsnorm(o_c, sub_g) * (1.0 - lam_init)).reshape(bsz, Lc, DA_WIDTH)
    y_c = y_cf + flip(y_cb) + dsk * xc.astype(jnp.float32)
    ssd_c = gated_out_norm(y_c, z_c, ssd_g)
    mix_c = jnp.concatenate([attn_c, ssd_c], axis=-1) @ w_out
    return mix_l, mix_c


def swiglu(h, w1, w2):
    gate, up = jnp.split(h @ w1, 2, axis=-1)
    return (jax.nn.silu(gate) * up) @ w2


def setup_inputs(seed: int = 0) -> dict:
    key = jax.random.key(seed)
    ks = jax.random.split(key, 20)
    f32 = jnp.float32
    s = D_MODEL ** -0.5
    dt0 = jnp.exp(jax.random.uniform(ks[9], (DEPTH, 2, SSD_HEADS), f32,
                                     math.log(1e-3), math.log(1e-1)))
    return {
        'x': jax.random.normal(ks[0], (BATCH, SEQ, D_MODEL), f32),
        'c': jax.random.normal(ks[1], (BATCH, D_MODEL), f32),
        'ctx': jax.random.normal(ks[2], (BATCH, CTX_LEN, D_MODEL), f32),
        'c_ctx': jax.random.normal(ks[3], (D_MODEL,), f32),
        'w_ada': jax.random.normal(ks[4], (DEPTH, D_MODEL, N_MOD * D_MODEL), f32) * (0.5 * s),
        'b_ada': jax.random.normal(ks[5], (DEPTH, N_MOD * D_MODEL), f32) * 0.01,
        'norm_g': 1.0 + 0.05 * jax.random.normal(ks[6], (DEPTH, 4, D_MODEL), f32),
        'w_in': jax.random.normal(ks[7], (DEPTH, D_MODEL, IN_COLS), f32) * s,
        'conv_w': jax.random.normal(ks[8], (DEPTH, SSD_CONV, SSD_CONV_CH), f32) * (SSD_CONV ** -0.5),
        'conv_b': jax.random.normal(ks[10], (DEPTH, SSD_CONV_CH), f32) * 0.01,
        'a_log': jnp.log(jax.random.uniform(ks[11], (DEPTH, 2, SSD_HEADS), f32, 1.0, 16.0)),
        'dt_bias': dt0 + jnp.log(-jnp.expm1(-dt0)),
        'd_skip': 1.0 + 0.05 * jax.random.normal(ks[12], (DEPTH, SSD_HEADS), f32),
        'ssd_norm_g': 1.0 + 0.05 * jax.random.normal(ks[13], (DEPTH, SSD_WIDTH), f32),
        'diff_lambda': 0.1 * jax.random.normal(ks[14], (DEPTH, 4, DA_HEAD_DIM), f32),
        'subln_g': 1.0 + 0.05 * jax.random.normal(ks[15], (DEPTH, DA_V_DIM), f32),
        'w_out': jax.random.normal(ks[16], (DEPTH, D_MIX, D_MODEL), f32) * (D_MIX ** -0.5),
        'w_ffn_in': jax.random.normal(ks[17], (DEPTH, D_MODEL, 2 * D_FF), f32) * s,
        'w_ffn_out': jax.random.normal(ks[18], (DEPTH, D_FF, D_MODEL), f32) * (D_FF ** -0.5),
    }


def reference(x, c, ctx, c_ctx, w_ada, b_ada, norm_g, w_in, conv_w, conv_b, a_log,
              dt_bias, d_skip, ssd_norm_g, diff_lambda, subln_g, w_out, w_ffn_in, w_ffn_out):
    L = x.shape[1]
    cos, sin = axial_rope_tables(L)
    sc = jax.nn.silu(c)
    scc = jax.nn.silu(c_ctx)
    for i in range(DEPTH):
        need_ctx = i < DEPTH - 1
        lam_init = 0.8 - 0.6 * math.exp(-0.3 * i)
        mod_l = (sc @ w_ada[i] + b_ada[i])[:, None, :]
        mod_c = (scc @ w_ada[i] + b_ada[i])[None, None, :]
        sh1, sc1, g1, sh2, sc2, g2 = jnp.split(mod_l, N_MOD, axis=-1)
        csh1, csc1, cg1, csh2, csc2, cg2 = jnp.split(mod_c, N_MOD, axis=-1)

        h_l = modulate(rmsnorm(x, norm_g[i, 0]), sh1, sc1)
        h_c = modulate(rmsnorm(ctx, norm_g[i, 0]), csh1, csc1)
        mix_l, mix_c = hybrid_mixer(h_l, h_c, w_in[i], conv_w[i], conv_b[i], a_log[i],
                                    dt_bias[i], d_skip[i], ssd_norm_g[i], diff_lambda[i],
                                    subln_g[i], w_out[i], lam_init, cos, sin, need_ctx)
        x = x + g1 * rmsnorm(mix_l, norm_g[i, 1])
        f_l = swiglu(modulate(rmsnorm(x, norm_g[i, 2]), sh2, sc2), w_ffn_in[i], w_ffn_out[i])
        x = x + g2 * rmsnorm(f_l, norm_g[i, 3])
        if need_ctx:
            ctx = ctx + cg1 * rmsnorm(mix_c, norm_g[i, 1])
            f_c = swiglu(modulate(rmsnorm(ctx, norm_g[i, 2]), csh2, csc2), w_ffn_in[i], w_ffn_out[i])
            ctx = ctx + cg2 * rmsnorm(f_c, norm_g[i, 3])
    return x
```

```cpp
#include <hip/hip_runtime.h>
#include <hip/hip_cooperative_groups.h>
#include <cstdio>
namespace cg = cooperative_groups;

typedef unsigned short u16;
typedef short bf16x8 __attribute__((ext_vector_type(8)));
typedef float f32x16 __attribute__((ext_vector_type(16)));
typedef __bf16 bf2_t __attribute__((ext_vector_type(2)));
typedef float f2_t __attribute__((ext_vector_type(2)));

#define DI __device__ __forceinline__
#define MFMA32(a, b, c) __builtin_amdgcn_mfma_f32_32x32x16_bf16((a), (b), (c), 0, 0, 0)

#ifndef MULTI_LAUNCH
#define MULTI_LAUNCH 0
#endif

constexpr int TLAT = 32768, TT = 33280, SEQ = 16384, NKEY = 16640;
constexpr int INC = 3088, DFF = 2816;
constexpr float EPS = 1e-6f;
constexpr size_t UB = (size_t)TT * 1024 * 2;
constexpr size_t OFF_WIN = 0;
constexpr size_t OFF_WOUT = OFF_WIN + 2ull * 3072 * 1024 * 2;
constexpr size_t OFF_WFI = OFF_WOUT + 2ull * 1024 * 1024 * 2;
constexpr size_t OFF_WFO = OFF_WFI + 2ull * 5632 * 1024 * 2;
constexpr size_t OFF_MOD = OFF_WFO + 2ull * 1024 * 2816 * 2;
constexpr size_t OFF_LAM = OFF_MOD + 2ull * 3 * 6144 * 4;
constexpr size_t OFF_DAC = OFF_LAM + 256;
constexpr size_t OFF_ROPE = OFF_DAC + 16640;
constexpr size_t OFF_XC = OFF_ROPE + 16384ull * 32 * 8;
constexpr size_t OFF_DTB = OFF_XC + 512ull * 1024 * 4;
constexpr size_t OFF_R0 = OFF_DTB + (size_t)TT * 16 * 4;
constexpr size_t OFF_R1 = OFF_R0 + UB;
constexpr size_t OFF_R3 = OFF_R1 + UB;
constexpr size_t OFF_R2 = OFF_R3 + UB;
constexpr size_t OFF_R4 = OFF_R2 + UB;
constexpr size_t OFF_R5 = OFF_R4 + UB;
constexpr size_t OFF_HB = OFF_R5 + 768ull * TT * 2;
constexpr size_t WS_END = OFF_HB + 2ull * 2 * 130 * 8 * 8192 * 2;
constexpr int SMEM_BYTES = 147456;

struct Params {
  const float *x, *c, *ctx, *c_ctx, *w_ada, *b_ada, *norm_g, *w_in, *conv_w, *conv_b, *a_log, *dt_bias, *d_skip,
      *ssd_norm_g, *diff_lambda, *subln_g, *w_out, *w_ffn_in, *w_ffn_out;
  float* out;
  unsigned char* ws;
};

DI unsigned pack2(float a, float b) {
  f2_t v = {a, b};
  bf2_t r = __builtin_convertvector(v, bf2_t);
  return __builtin_bit_cast(unsigned, r);
}
DI float blo(unsigned u) { return __uint_as_float(u << 16); }
DI float bhi(unsigned u) { return __uint_as_float(u & 0xffff0000u); }
DI float bf2f(u16 u) { return __uint_as_float(((unsigned)u) << 16); }
DI int crow(int i, int h) { return (i & 3) + 8 * (i >> 2) + 4 * h; }
DI float silu_f(float x) { return x * __builtin_amdgcn_rcpf(1.f + __expf(-x)); }
DI float wave_sum(float v) {
#pragma unroll
  for (int o = 32; o; o >>= 1) v += __shfl_xor(v, o);
  return v;
}
DI bf16x8 mk8(unsigned a, unsigned b, unsigned c, unsigned d) {
  uint4 u = {a, b, c, d};
  return __builtin_bit_cast(bf16x8, u);
}
DI int tid_() { int t = threadIdx.x; asm volatile("" : "+v"(t)); return t; }
DI int bid_() { int b = blockIdx.x; asm volatile("" : "+s"(b)); return b; }
DI int vblock() {
  int nb = gridDim.x, bid = bid_();
  return (nb % 8 == 0) ? (bid % 8) * (nb / 8) + bid / 8 : bid;
}

DI void transpose_tile(const float* __restrict__ W, int ldw, int k0, int n0, int ffn_q, u16* __restrict__ Wt, int K,
                       int dstrow0, unsigned char* st, int lane) {
  const int nn = (lane & 15) * 4;
  const int src = (ffn_q >= 0) ? (nn < 32 ? 32 * ffn_q + nn : DFF + 32 * ffn_q + nn - 32) : n0 + nn;
  float4 v[16];
#pragma unroll
  for (int j = 0; j < 16; ++j) v[j] = *(const float4*)(W + (size_t)(k0 + (lane >> 4) + 4 * j) * ldw + src);
#pragma unroll
  for (int j = 0; j < 16; ++j) {
    const int kk = (lane >> 4) + 4 * j;
    unsigned a = pack2(v[j].x, v[j].y), b = pack2(v[j].z, v[j].w);
    *(u16*)(st + (nn + 0) * 144 + kk * 2) = (u16)(a & 0xffffu);
    *(u16*)(st + (nn + 1) * 144 + kk * 2) = (u16)(a >> 16);
    *(u16*)(st + (nn + 2) * 144 + kk * 2) = (u16)(b & 0xffffu);
    *(u16*)(st + (nn + 3) * 144 + kk * 2) = (u16)(b >> 16);
  }
  __builtin_amdgcn_wave_barrier();
#pragma unroll
  for (int j = 0; j < 8; ++j) {
    const int row = (lane >> 3) + 8 * j, k8 = (lane & 7) * 8;
    uint4 o = *(const uint4*)(st + row * 144 + k8 * 2);
    *(uint4*)(Wt + (size_t)(dstrow0 + row) * K + k0 + k8) = o;
  }
  __builtin_amdgcn_wave_barrier();
}

DI void prologue_phase(const Params& p, unsigned char* smem) {
  const int tid = tid_(), lane = tid & 63, w = tid >> 6;
  float* st = (float*)smem;
  float* sv = (float*)(smem + 16640);
  float* red = (float*)(smem + 16640 + 12288);
  float* modb = (float*)(p.ws + OFF_MOD);
  for (int i = tid; i < 3072; i += 512) {
    int v = i >> 10, k = i & 1023;
    float cv = (v < 2) ? p.c[v * 1024 + k] : p.c_ctx[k];
    sv[i] = cv / (1.f + expf(-cv));
  }
  __syncthreads();
  const int nb = gridDim.x;
  const int NGEMV = 192, NTR = 3136 * 2;
  for (int it = bid_(); it < NGEMV; it += nb) {
    {
      int L = it / 96, chunk = it % 96;
      int col = chunk * 64 + lane;
      const float* wp = p.w_ada + (size_t)L * 1024 * 6144 + col;
      float a0 = 0.f, a1 = 0.f, a2 = 0.f;
#pragma unroll 16
      for (int kk = 0; kk < 128; ++kk) {
        int k = w * 128 + kk;
        float wv = wp[(size_t)k * 6144];
        a0 += sv[k] * wv;
        a1 += sv[1024 + k] * wv;
        a2 += sv[2048 + k] * wv;
      }
      red[(w * 3 + 0) * 64 + lane] = a0;
      red[(w * 3 + 1) * 64 + lane] = a1;
      red[(w * 3 + 2) * 64 + lane] = a2;
      __syncthreads();
      if (tid < 192) {
        int v = tid >> 6, ln = tid & 63;
        float s = 0.f;
#pragma unroll
        for (int ww = 0; ww < 8; ++ww) s += red[(ww * 3 + v) * 64 + ln];
        s += p.b_ada[L * 6144 + chunk * 64 + ln];
        modb[(L * 3 + v) * 6144 + chunk * 64 + ln] = s;
      }
      __syncthreads();
    }
  }
  {
    unsigned char* stw = smem + 40960 + w * 9216;
    for (int t = vblock() * 8 + w; t < NTR; t += nb * 8) {
      int L = t / 3136, idx = t % 3136;
      if (idx < 768) {
        int kt = idx / 48, nt = idx % 48;
        transpose_tile(p.w_in + (size_t)L * 1024 * INC, INC, kt * 64, nt * 64, -1,
                       (u16*)(p.ws + OFF_WIN) + (size_t)L * 3072 * 1024, 1024, nt * 64, stw, lane);
      } else if (idx < 1024) {
        int i2 = idx - 768, kt = i2 / 16, nt = i2 % 16;
        transpose_tile(p.w_out + (size_t)L * 1024 * 1024, 1024, kt * 64, nt * 64, -1,
                       (u16*)(p.ws + OFF_WOUT) + (size_t)L * 1024 * 1024, 1024, nt * 64, stw, lane);
      } else if (idx < 2432) {
        int i3 = idx - 1024, kt = i3 / 88, q = i3 % 88;
        transpose_tile(p.w_ffn_in + (size_t)L * 1024 * 5632, 5632, kt * 64, 0, q,
                       (u16*)(p.ws + OFF_WFI) + (size_t)L * 5632 * 1024, 1024, q * 64, stw, lane);
      } else {
        int i4 = idx - 2432, kt = i4 / 16, nt = i4 % 16;
        transpose_tile(p.w_ffn_out + (size_t)L * DFF * 1024, 1024, kt * 64, nt * 64, -1,
                       (u16*)(p.ws + OFF_WFO) + (size_t)L * 1024 * DFF, DFF, nt * 64, stw, lane);
      }
    }
  }
  float2* rope = (float2*)(p.ws + OFF_ROPE);
  for (int i = bid_() * 512 + tid; i < SEQ * 32; i += nb * 512) {
    int t = i >> 5, c = i & 31;
    float inv = powf(10000.f, -(float)(c & 15) / 16.f);
    float pos = (c < 16) ? (float)(t >> 6) : (float)(t & 63);
    float ang = pos * inv;
    rope[i] = make_float2(cosf(ang), sinf(ang));
  }
  if (bid_() == 0 && tid == 0) *(volatile unsigned*)(p.ws + OFF_LAM + 128) = 0u;
  if (bid_() == 0 && w < 2) {
    int L = w;
    const float* lv = p.diff_lambda + L * 256;
    float s01 = wave_sum(lv[lane] * lv[64 + lane]);
    float s23 = wave_sum(lv[128 + lane] * lv[192 + lane]);
    float lam_init = 0.8f - 0.6f * expf(-0.3f * (float)L);
    if (lane == 0) ((float*)(p.ws + OFF_LAM))[L] = expf(s01) - expf(s23) + lam_init;
  }
}

template <int MODE>
DI void norm_phase(const Params& p, int L, unsigned char* smem) {
  const int tid = tid_(), lane = tid & 63, w = tid >> 6;
  const int Lh = (MODE == 2) ? L + 1 : L;
  const bool do_h = (MODE != 2) || (L + 1 < 2);
  const bool do_dt = (MODE == 0) || (MODE == 2 && do_h);
  float* sW = (float*)smem;
  if (do_dt) {
    const float* wdt = p.w_in + (size_t)Lh * 1024 * INC + 3072;
#pragma unroll 8
    for (int i = tid; i < 16384; i += 512) {
      int k = i >> 4, c = i & 15;
      int kq = k >> 8, kk = k & 255;
      sW[(((kk >> 2) * 64 + kq * 16 + c) * 4) + (kk & 3)] = wdt[(size_t)k * INC + c];
    }
    __syncthreads();
  }
  const float* modL = (const float*)(p.ws + OFF_MOD) + L * 3 * 6144;
  const float* modH = (const float*)(p.ws + OFF_MOD) + (do_h ? Lh : 0) * 3 * 6144;
  float* xc = (float*)(p.ws + OFF_XC);
  const u16* br = (const u16*)(p.ws + OFF_R1);
  u16* hbuf = (u16*)(p.ws + OFF_R0);
  float* dtb = (float*)(p.ws + OFF_DTB);
  const int nb = gridDim.x;
  auto load_row = [&](int row, float (&xv)[16], float (&bv)[16]) {
    const float* xold;
    if (row < TLAT) xold = ((MODE == 0 || (MODE == 1 && L == 0)) ? p.x : p.out) + (size_t)row * 1024;
    else xold = ((MODE == 0 || (MODE == 1 && L == 0)) ? p.ctx : xc) + (size_t)(row - TLAT) * 1024;
#pragma unroll
    for (int j = 0; j < 2; ++j) {
      int c0 = j * 512 + lane * 8;
      float4 a = *(const float4*)(xold + c0), b = *(const float4*)(xold + c0 + 4);
      xv[j * 8 + 0] = a.x; xv[j * 8 + 1] = a.y; xv[j * 8 + 2] = a.z; xv[j * 8 + 3] = a.w;
      xv[j * 8 + 4] = b.x; xv[j * 8 + 5] = b.y; xv[j * 8 + 6] = b.z; xv[j * 8 + 7] = b.w;
    }
    if (MODE != 0) {
#pragma unroll
      for (int j = 0; j < 2; ++j) {
        uint4 u = *(const uint4*)(br + (size_t)row * 1024 + j * 512 + lane * 8);
        bv[j * 8 + 0] = blo(u.x); bv[j * 8 + 1] = bhi(u.x); bv[j * 8 + 2] = blo(u.y); bv[j * 8 + 3] = bhi(u.y);
        bv[j * 8 + 4] = blo(u.z); bv[j * 8 + 5] = bhi(u.z); bv[j * 8 + 6] = blo(u.w); bv[j * 8 + 7] = bhi(u.w);
      }
    }
  };
  auto process_row = [&](int row, float (&xv)[16], float (&bv)[16]) {
    const int v = (row < TLAT) ? (row >> 14) : 2;
    float* xnew = (row < TLAT) ? p.out + (size_t)row * 1024 : xc + (size_t)(row - TLAT) * 1024;
    if (MODE != 0) {
      float ssq = 0.f;
#pragma unroll
      for (int e = 0; e < 16; ++e) ssq += bv[e] * bv[e];
      ssq = wave_sum(ssq);
      const float rstd = rsqrtf(ssq * (1.f / 1024.f) + EPS);
      const float* g = p.norm_g + (L * 4 + (MODE == 1 ? 1 : 3)) * 1024;
      const float* gate = modL + v * 6144 + (MODE == 1 ? 2 : 5) * 1024;
#pragma unroll
      for (int j = 0; j < 2; ++j) {
        int c0 = j * 512 + lane * 8;
#pragma unroll
        for (int e = 0; e < 8; ++e) xv[j * 8 + e] += gate[c0 + e] * (bv[j * 8 + e] * rstd * g[c0 + e]);
        *(float4*)(xnew + c0) = make_float4(xv[j * 8 + 0], xv[j * 8 + 1], xv[j * 8 + 2], xv[j * 8 + 3]);
        *(float4*)(xnew + c0 + 4) = make_float4(xv[j * 8 + 4], xv[j * 8 + 5], xv[j * 8 + 6], xv[j * 8 + 7]);
      }
    }
    if (do_h) {
      float ssq = 0.f;
#pragma unroll
      for (int e = 0; e < 16; ++e) ssq += xv[e] * xv[e];
      ssq = wave_sum(ssq);
      const float rstd = rsqrtf(ssq * (1.f / 1024.f) + EPS);
      const float* g = p.norm_g + (Lh * 4 + (MODE == 1 ? 2 : 0)) * 1024;
      const float* sh = modH + v * 6144 + (MODE == 1 ? 3 : 0) * 1024;
      const float* sc = modH + v * 6144 + (MODE == 1 ? 4 : 1) * 1024;
#pragma unroll
      for (int j = 0; j < 2; ++j) {
        int c0 = j * 512 + lane * 8;
#pragma unroll
        for (int e = 0; e < 8; ++e) xv[j * 8 + e] = xv[j * 8 + e] * rstd * g[c0 + e] * (1.f + sc[c0 + e]) + sh[c0 + e];
        uint4 o = {pack2(xv[j * 8 + 0], xv[j * 8 + 1]), pack2(xv[j * 8 + 2], xv[j * 8 + 3]),
                   pack2(xv[j * 8 + 4], xv[j * 8 + 5]), pack2(xv[j * 8 + 6], xv[j * 8 + 7])};
        *(uint4*)(hbuf + (size_t)row * 1024 + c0) = o;
      }
      if (do_dt) {
        float* hw = (float*)(smem + 65536) + w * 1040;
#pragma unroll
        for (int j = 0; j < 2; ++j) {
          int c0 = j * 512 + lane * 8, kq = c0 >> 8, kk = c0 & 255;
          *(float4*)(hw + kq * 260 + kk) = make_float4(xv[j * 8 + 0], xv[j * 8 + 1], xv[j * 8 + 2], xv[j * 8 + 3]);
          *(float4*)(hw + kq * 260 + kk + 4) = make_float4(xv[j * 8 + 4], xv[j * 8 + 5], xv[j * 8 + 6], xv[j * 8 + 7]);
        }
        __builtin_amdgcn_wave_barrier();
        const float* wq = sW + ((lane >> 4) * 16 + (lane & 15)) * 4;
        const float* hq = hw + (lane >> 4) * 260;
        float acc = 0.f;
#pragma unroll 8
        for (int k4 = 0; k4 < 64; ++k4) {
          float4 wv = *(const float4*)(wq + k4 * 256);
          float4 hv = *(const float4*)(hq + k4 * 4);
          acc += wv.x * hv.x + wv.y * hv.y + wv.z * hv.z + wv.w * hv.w;
        }
        acc += __shfl_xor(acc, 16);
        acc += __shfl_xor(acc, 32);
        __builtin_amdgcn_wave_barrier();
        if (lane < 16) {
          float xx = acc + p.dt_bias[Lh * 16 + lane];
          dtb[(size_t)row * 16 + lane] = fmaxf(xx, 0.f) + log1pf(expf(-fabsf(xx)));
        }
      }
    }
  };
  const int NP = ((MODE != 0 && L == 1) ? TLAT : TT) / 2;
  for (int pr = bid_() * 8 + w; pr < NP; pr += nb * 8) {
    float xa[16], xb[16], ba[16], bb[16];
    load_row(2 * pr, xa, ba);
    load_row(2 * pr + 1, xb, bb);
    process_row(2 * pr, xa, ba);
    process_row(2 * pr + 1, xb, bb);
  }
}

enum { EPI_PLAIN = 0, EPI_INPROJ = 1, EPI_FFNIN = 2 };
struct EpiArgs {
  u16* dst;
  int ldd;
  u16 *qk, *vT, *zb, *xraw;
  const float2* rope;
};

template <int EPI, int MT = 4>
DI void gemm_phase(const u16* A, int lda, const u16* Bt, int ldb, int K, int ntn, int nmt, int mrow0,
                   const EpiArgs& ea, unsigned char* smem) {
  const int tid = tid_(), lane = tid & 63, w = tid >> 6, wm = w >> 2, wn = w & 3;
  const int r = lane & 31, h = lane >> 5;
  const int nk = K / 64;
  const int ntiles = nmt * ntn;
  const int nb = gridDim.x;
  for (int tile = vblock(); tile < ntiles; tile += nb) {
    const int nig = 8 * ntn, gid = tile / nig, fm = gid * 8, gsz = min(nmt - fm, 8);
    const int mtile = fm + (tile % nig) % gsz, ntile = (tile % nig) / gsz;
    const int m0 = mrow0 + mtile * (64 * MT), n0 = ntile * 256;
    f32x16 acc[MT][2];
#pragma unroll
    for (int a = 0; a < MT; ++a)
#pragma unroll
      for (int b = 0; b < 2; ++b)
#pragma unroll
        for (int i = 0; i < 16; ++i) acc[a][b][i] = 0.f;
    const int sws = (tid & 7) ^ ((tid >> 4) & 7);
    const u16* Ap = A + (size_t)(m0 + (tid >> 3)) * lda + sws * 8;
    const u16* Bp = Bt + (size_t)(n0 + (tid >> 3)) * ldb + sws * 8;
#define GLDS(kt, stg)                                                                                         \
  {                                                                                                           \
    unsigned char* ld_ = smem + (stg) * 65536 + tid * 16;                                                     \
    _Pragma("unroll") for (int j = 0; j < MT; ++j)                                                            \
      __builtin_amdgcn_global_load_lds((const unsigned*)(Ap + (size_t)(64 * j) * lda + (kt) * 64),            \
                                       (unsigned*)(ld_ + j * 8192), 16, 0, 0);                                \
    _Pragma("unroll") for (int j = 0; j < 4; ++j)                                                             \
      __builtin_amdgcn_global_load_lds((const unsigned*)(Bp + (size_t)(64 * j) * ldb + (kt) * 64),            \
                                       (unsigned*)(ld_ + 32768 + j * 8192), 16, 0, 0);                        \
  }
    const int xr = (r >> 1) & 7;
    const int fo0 = ((0 + h) ^ xr) * 16, fo1 = ((2 + h) ^ xr) * 16, fo2 = ((4 + h) ^ xr) * 16, fo3 = ((6 + h) ^ xr) * 16;
    GLDS(0, 0);
    asm volatile("s_waitcnt vmcnt(0)" ::: "memory");
    __syncthreads();
    for (int kt = 0; kt < nk; ++kt) {
      if (kt + 1 < nk) GLDS(kt + 1, (kt + 1) & 1);
      asm volatile("" ::: "memory");
      __builtin_amdgcn_sched_barrier(0);
      const unsigned char* sa = smem + (kt & 1) * 65536 + (wm * (32 * MT) + r) * 128;
      const unsigned char* sb = smem + (kt & 1) * 65536 + 32768 + (wn * 64 + r) * 128;
#pragma unroll
      for (int ks = 0; ks < 4; ++ks) {
        const int fo = (ks == 0) ? fo0 : (ks == 1) ? fo1 : (ks == 2) ? fo2 : fo3;
        bf16x8 af[MT], bfr[2];
#pragma unroll
        for (int a = 0; a < MT; ++a) af[a] = *(const bf16x8*)(sa + a * 32 * 128 + fo);
#pragma unroll
        for (int b = 0; b < 2; ++b) bfr[b] = *(const bf16x8*)(sb + b * 32 * 128 + fo);
#pragma unroll
        for (int a = 0; a < MT; ++a)
#pragma unroll
          for (int b = 0; b < 2; ++b) acc[a][b] = MFMA32(af[a], bfr[b], acc[a][b]);
      }
      if (MT == 4) {
        __builtin_amdgcn_sched_group_barrier(0x100, 8, 0);
#pragma unroll
        for (int g_ = 0; g_ < 16; ++g_) {
          __builtin_amdgcn_sched_group_barrier(0x8, 1, 0);
          __builtin_amdgcn_sched_group_barrier(0x100, 1, 0);
        }
        __builtin_amdgcn_sched_group_barrier(0x8, 16, 0);
      }
      __builtin_amdgcn_sched_barrier(0);
      asm volatile("s_waitcnt vmcnt(0)" ::: "memory");
      __syncthreads();
    }
#undef GLDS
    int te = tid;
    asm volatile("" : "+v"(te));
    {
    const int tid = te, lane = tid & 63, w = tid >> 6, wm = w >> 2, wn = w & 3;
    const int r = lane & 31, h = lane >> 5;
    (void)lane; (void)w;
    if (EPI == EPI_FFNIN) {
#pragma unroll
      for (int a = 0; a < MT; ++a)
#pragma unroll
        for (int i = 0; i < 16; ++i) {
          float gte = acc[a][0][i], up = acc[a][1][i];
          float vv = silu_f(gte) * up;
          int row = wm * (32 * MT) + a * 32 + crow(i, h);
          *(u16*)(smem + row * 272 + (wn * 32 + r) * 2) = (u16)(pack2(vv, 0.f) & 0xffffu);
        }
      __syncthreads();
#pragma unroll
      for (int j = 0; j < 2 * MT; ++j) {
        int c = tid + 512 * j, row = c >> 4, ch = c & 15;
        uint4 v = *(const uint4*)(smem + row * 272 + ch * 16);
        *(uint4*)(ea.dst + (size_t)(m0 + row) * ea.ldd + ntile * 128 + ch * 8) = v;
      }
      __syncthreads();
    } else {
      bool transposed = false;
      if (EPI == EPI_INPROJ) {
        transposed = (ntile == 4 || ntile == 5);
        if (ntile < 4 && MT == 4 && mtile < 128) {
#pragma unroll
          for (int a = 0; a < MT; ++a)
#pragma unroll
            for (int i = 0; i < 16; ++i) {
              int row = wm * (32 * MT) + a * 32 + crow(i, h);
              int t = (m0 + row) & (SEQ - 1);
              float2 cs = ea.rope[t * 32 + r];
              float u1 = acc[a][0][i], u2 = acc[a][1][i];
              acc[a][0][i] = u1 * cs.x - u2 * cs.y;
              acc[a][1][i] = u1 * cs.y + u2 * cs.x;
            }
        }
      }
      if (!transposed) {
#pragma unroll
        for (int a = 0; a < MT; ++a)
#pragma unroll
          for (int b = 0; b < 2; ++b)
#pragma unroll
            for (int i = 0; i < 16; ++i) {
              int row = wm * (32 * MT) + a * 32 + crow(i, h);
              int col = wn * 64 + b * 32 + r;
              *(u16*)(smem + row * 528 + col * 2) = (u16)(pack2(acc[a][b][i], 0.f) & 0xffffu);
            }
      } else {
#pragma unroll
        for (int a = 0; a < MT; ++a)
#pragma unroll
          for (int b = 0; b < 2; ++b)
#pragma unroll
            for (int g = 0; g < 4; ++g) {
              int col = wn * 64 + b * 32 + r;
              int row = wm * (32 * MT) + a * 32 + 8 * g + 4 * h;
              uint2 v = {pack2(acc[a][b][4 * g + 0], acc[a][b][4 * g + 1]), pack2(acc[a][b][4 * g + 2], acc[a][b][4 * g + 3])};
              *(uint2*)(smem + col * 528 + row * 2) = v;
            }
      }
      __syncthreads();
      u16* dbase;
      size_t dld;
      if (EPI == EPI_PLAIN) {
        dbase = ea.dst + (size_t)m0 * ea.ldd + n0;
        dld = ea.ldd;
      } else {
        if (ntile < 4) {
          dbase = ea.qk + (size_t)m0 * 1024 + n0;
          dld = 1024;
        } else if (ntile < 6) {
          int b = (MT == 1) ? (mtile >> 2) : ((mtile < 128) ? (mtile >> 6) : (mtile - 128));
          int keybase = (MT == 1) ? (mtile & 3) * 64 : ((mtile < 128) ? 256 + (mtile & 63) * 256 : 0);
          dbase = ea.vT + ((size_t)(b * 4) * 128 + (size_t)(ntile - 4) * 256) * NKEY + keybase;
          dld = NKEY;
        } else if (ntile < 8) {
          dbase = ea.zb + (size_t)m0 * 512 + (ntile - 6) * 256;
          dld = 512;
        } else {
          dbase = ea.xraw + (size_t)m0 * 1024 + (ntile - 8) * 256;
          dld = 1024;
        }
      }
      if (MT == 1 && transposed) {
#pragma unroll
        for (int j = 0; j < 4; ++j) {
          const int c = tid + 512 * j, row = c >> 3, ch = c & 7;
          uint4 v = *(const uint4*)(smem + row * 528 + ch * 16);
          *(uint4*)(dbase + (size_t)row * dld + ch * 8) = v;
        }
      } else {
        const unsigned char* sp = smem + (tid >> 5) * 528 + (tid & 31) * 16;
        u16* dp = dbase + (size_t)(tid >> 5) * dld + (tid & 31) * 8;
#pragma unroll 4
        for (int j = 0; j < 4 * MT; ++j) {
          uint4 v = *(const uint4*)sp;
          *(uint4*)dp = v;
          sp += 16 * 528;
          dp += 16 * dld;
        }
      }
      __syncthreads();
    }
    }
  }
}

DI void conv_item(const Params& p, int L, int item, unsigned char* smem) {
  const int tid = tid_();
  const u16* xraw = (const u16*)(p.ws + OFF_R3);
  u16* xbcc = (u16*)(p.ws + OFF_R0);
  u16* xbcT = (u16*)(p.ws + OFF_R5);
  const int cgk = item >> 2, slab = item & 3;
  const int row0 = cgk * 128;
  int lo, hi;
  if (cgk < 256) { lo = (cgk >> 7) * SEQ; hi = lo + SEQ; }
  else { lo = TLAT + ((cgk - 256) >> 1) * 256; hi = lo + 256; }
  unsigned char* sRaw = smem;
  unsigned char* sT = smem + 69696;
  for (int c = tid; c < 132 * 32; c += 512) {
    int rr = c >> 5, ch = c & 31;
    int grow = row0 - 2 + rr;
    uint4 v = {0u, 0u, 0u, 0u};
    if (grow >= lo && grow < hi) v = *(const uint4*)(xraw + (size_t)grow * 1024 + slab * 256 + ch * 8);
    *(uint4*)(sRaw + rr * 528 + ch * 16) = v;
  }
  __syncthreads();
  const int ch8 = tid & 31, cbase = slab * 256 + ch8 * 8;
  float wgt[5][8], bias8[8];
  {
    float4 b0 = *(const float4*)(p.conv_b + L * 1024 + cbase), b1 = *(const float4*)(p.conv_b + L * 1024 + cbase + 4);
    bias8[0] = b0.x; bias8[1] = b0.y; bias8[2] = b0.z; bias8[3] = b0.w; bias8[4] = b1.x; bias8[5] = b1.y; bias8[6] = b1.z; bias8[7] = b1.w;
#pragma unroll
    for (int jj = 0; jj < 5; ++jj) {
      const float* wp = p.conv_w + (size_t)(L * 5 + jj) * 1024 + cbase;
      float4 w0 = *(const float4*)wp, w1 = *(const float4*)(wp + 4);
      wgt[jj][0] = w0.x; wgt[jj][1] = w0.y; wgt[jj][2] = w0.z; wgt[jj][3] = w0.w;
      wgt[jj][4] = w1.x; wgt[jj][5] = w1.y; wgt[jj][6] = w1.z; wgt[jj][7] = w1.w;
    }
  }
#pragma unroll 2
  for (int j = 0; j < 8; ++j) {
    int t = (tid >> 5) + 16 * j;
    float acc[8];
#pragma unroll
    for (int e = 0; e < 8; ++e) acc[e] = bias8[e];
#pragma unroll
    for (int jj = 0; jj < 5; ++jj) {
      uint4 v = *(const uint4*)(sRaw + (t + jj) * 528 + ch8 * 16);
      acc[0] += wgt[jj][0] * blo(v.x); acc[1] += wgt[jj][1] * bhi(v.x); acc[2] += wgt[jj][2] * blo(v.y); acc[3] += wgt[jj][3] * bhi(v.y);
      acc[4] += wgt[jj][4] * blo(v.z); acc[5] += wgt[jj][5] * bhi(v.z); acc[6] += wgt[jj][6] * blo(v.w); acc[7] += wgt[jj][7] * bhi(v.w);
    }
#pragma unroll
    for (int e = 0; e < 8; ++e) acc[e] = silu_f(acc[e]);
    uint4 o = {pack2(acc[0], acc[1]), pack2(acc[2], acc[3]), pack2(acc[4], acc[5]), pack2(acc[6], acc[7])};
    *(uint4*)(xbcc + (size_t)(row0 + t) * 1024 + cbase) = o;
    if (slab < 3) {
      unsigned char* d = sT + (ch8 * 8) * 272 + t * 2;
      *(u16*)(d + 0 * 272) = (u16)(o.x & 0xffffu); *(u16*)(d + 1 * 272) = (u16)(o.x >> 16);
      *(u16*)(d + 2 * 272) = (u16)(o.y & 0xffffu); *(u16*)(d + 3 * 272) = (u16)(o.y >> 16);
      *(u16*)(d + 4 * 272) = (u16)(o.z & 0xffffu); *(u16*)(d + 5 * 272) = (u16)(o.z >> 16);
      *(u16*)(d + 6 * 272) = (u16)(o.w & 0xffffu); *(u16*)(d + 7 * 272) = (u16)(o.w >> 16);
    }
  }
  __syncthreads();
  if (slab < 3) {
#pragma unroll
    for (int j = 0; j < 8; ++j) {
      int c = tid + 512 * j, ch = c >> 4, t8 = c & 15;
      uint4 v = *(const uint4*)(sT + ch * 272 + t8 * 16);
      *(uint4*)(xbcT + (size_t)(slab * 256 + ch) * TT + row0 + t8 * 8) = v;
    }
  }
  __syncthreads();
}

#pragma float_control(push)
#pragma float_control(precise, off)
DI void attn_unit(const Params& p, int L, int unit, unsigned char* smem) {
  const int tid = tid_(), lane = tid & 63, w = tid >> 6;
  const int r = lane & 31, h = lane >> 5;
  const int m = w & 1, qs = w >> 1;
  const u16* qk = (const u16*)(p.ws + OFF_R1);
  const u16* vT = (const u16*)(p.ws + OFF_R2);
  u16* mixin = (u16*)(p.ws + OFF_R4);
  const float lam = ((const float*)(p.ws + OFF_LAM))[L];
  const float lam_init = 0.8f - 0.6f * expf(-0.3f * (float)L);
  int b, hh, qrow0, nkt;
  if (unit < 1024) { b = unit >> 9; hh = (unit >> 7) & 3; qrow0 = b * SEQ + (unit & 127) * 128; nkt = NKEY / 64; }
  else { int u2 = unit - 1024; b = u2 >> 3; hh = (u2 >> 1) & 3; qrow0 = TLAT + b * 256 + (u2 & 1) * 128; nkt = 4; }
  const int ctxrow0 = TLAT + b * 256, latrow0 = b * SEQ - 256;
  bf16x8 Qf[4];
  {
    const float qsc = 0.125f * 1.4426950408889634f;
    const u16* qp = qk + (size_t)(qrow0 + qs * 32 + r) * 1024 + hh * 128 + m * 64 + h * 8;
#pragma unroll
    for (int ks = 0; ks < 4; ++ks) {
      uint4 u = *(const uint4*)(qp + ks * 16);
      Qf[ks] = mk8(pack2(blo(u.x) * qsc, bhi(u.x) * qsc), pack2(blo(u.y) * qsc, bhi(u.y) * qsc),
                   pack2(blo(u.z) * qsc, bhi(u.z) * qsc), pack2(blo(u.w) * qsc, bhi(u.w) * qsc));
    }
  }
  f32x16 O[4];
#pragma unroll
  for (int e = 0; e < 4; ++e)
#pragma unroll
    for (int i = 0; i < 16; ++i) O[e][i] = 0.f;
  const u16* kcol = qk + 512 + hh * 128 + (((tid & 15) ^ ((tid >> 4) & 15)) * 8);
  const u16* vbase = vT + ((size_t)(b * 4 + hh) * 128 + (tid >> 3)) * NKEY + (((tid & 7) ^ ((tid >> 4) & 7)) * 8);
#define KGLDS(kt, stg)                                                                                         \
  {                                                                                                            \
    int kk0 = (kt) * 64;                                                                                       \
    int krow = (kk0 < 256) ? (ctxrow0 + kk0) : (latrow0 + kk0);                                                \
    unsigned char* ld_ = smem + (stg) * 16384 + tid * 16;                                                      \
    __builtin_amdgcn_global_load_lds((const unsigned*)(kcol + (size_t)(krow + (tid >> 4)) * 1024), (unsigned*)(ld_), 16, 0, 0);            \
    __builtin_amdgcn_global_load_lds((const unsigned*)(kcol + (size_t)(krow + (tid >> 4) + 32) * 1024), (unsigned*)(ld_ + 8192), 16, 0, 0); \
  }
#define VGLDS(kt, stg)                                                                                         \
  {                                                                                                            \
    unsigned char* ld_ = smem + 65536 + (stg) * 16384 + tid * 16;                                              \
    __builtin_amdgcn_global_load_lds((const unsigned*)(vbase + (kt) * 64), (unsigned*)(ld_), 16, 0, 0);        \
    __builtin_amdgcn_global_load_lds((const unsigned*)(vbase + (size_t)64 * NKEY + (kt) * 64), (unsigned*)(ld_ + 8192), 16, 0, 0); \
  }
  const int kpr = (r & 0x13) | ((r & 4) << 1) | ((r & 8) >> 1);
  const float THR = 8.f;
  f32x16 zero16;
#pragma unroll
  for (int i = 0; i < 16; ++i) zero16[i] = 0.f;
  float mrun = 0.f, lrun = 0.f;
  const bf16x8 Kb = mk8(h == 0 ? 0x3F80u : 0u, 0u, 0u, 0u);
  bf16x8 Qb = mk8(0u, 0u, 0u, 0u);
  const unsigned char* kbase = smem + kpr * 256;
  const int kx = kpr & 15, vx = (r >> 1) & 7;
  const int ko0 = ((m * 8 + 0 + h) ^ kx) * 16, ko1 = ((m * 8 + 2 + h) ^ kx) * 16, ko2 = ((m * 8 + 4 + h) ^ kx) * 16,
            ko3 = ((m * 8 + 6 + h) ^ kx) * 16;
  const int vo0 = ((0 + h) ^ vx) * 16, vo1 = ((2 + h) ^ vx) * 16, vo2 = ((4 + h) ^ vx) * 16, vo3 = ((6 + h) ^ vx) * 16;
  const unsigned char* vbase_l = smem + 65536 + r * 128;
#define SCOMP(stg, SA, SB)                                                        \
  {                                                                               \
    const unsigned char* kb = kbase + (stg) * 16384;                              \
    SA = MFMA32(Kb, Qb, zero16);                                                  \
    SB = MFMA32(Kb, Qb, zero16);                                                  \
    SA = MFMA32(*(const bf16x8*)(kb + ko0), Qf[0], SA);                                 \
    SB = MFMA32(*(const bf16x8*)(kb + 8192 + ko0), Qf[0], SB);                      \
    SA = MFMA32(*(const bf16x8*)(kb + ko1), Qf[1], SA);                            \
    SB = MFMA32(*(const bf16x8*)(kb + 8192 + ko1), Qf[1], SB);                 \
    SA = MFMA32(*(const bf16x8*)(kb + ko2), Qf[2], SA);                            \
    SB = MFMA32(*(const bf16x8*)(kb + 8192 + ko2), Qf[2], SB);                 \
    SA = MFMA32(*(const bf16x8*)(kb + ko3), Qf[3], SA);                            \
    SB = MFMA32(*(const bf16x8*)(kb + 8192 + ko3), Qf[3], SB);                 \
  }
#define TILEMAX(SA, SB, out)                                                      \
  {                                                                               \
    float t_ = fmaxf(SA[0], SB[0]);                                               \
    _Pragma("unroll") for (int i = 1; i < 16; ++i) t_ = fmaxf(t_, fmaxf(SA[i], SB[i])); \
    out = fmaxf(t_, __shfl_xor(t_, 32));                                          \
  }
#define LDF(p_) (*(const bf16x8*)(p_))
#define GRP(nm, vpm)                                                                  \
  __builtin_amdgcn_sched_group_barrier(0x100, 4, 0);                                  \
  _Pragma("unroll") for (int g_ = 0; g_ < (nm); ++g_) {                               \
    __builtin_amdgcn_sched_group_barrier(0x8, 1, 0);                                  \
    __builtin_amdgcn_sched_group_barrier(0x402, (vpm), 0);                            \
  }                                                                                   \
  __builtin_amdgcn_sched_barrier(0);
#define FB(x_) __float_as_int(x_)
#define PMAX4(SA, SB, i0, acc_)                                                       \
  acc_ = max(acc_, max(max(FB(SA[i0]), FB(SB[i0])), max(FB(SA[i0 + 1]), FB(SB[i0 + 1]))));            \
  acc_ = max(acc_, max(max(FB(SA[i0 + 2]), FB(SB[i0 + 2])), max(FB(SA[i0 + 3]), FB(SB[i0 + 3]))));
#define ASTEP(KT, CA, CB, NA, NB)                                                                        \
  {                                                                                                      \
    const int kt_ = (KT);                                                                                \
    if (kt_ + 3 < nkt) KGLDS(kt_ + 3, (kt_ + 3) & 3);                                                    \
    if (kt_ + 2 < nkt) VGLDS(kt_ + 2, (kt_ + 2) & 3);                                                    \
    __builtin_amdgcn_sched_barrier(0);                                                                   \
    const unsigned char* kb = kbase + ((kt_ + 1) & 3) * 16384;                                           \
    const unsigned char* vb = vbase_l + (kt_ & 3) * 16384;                                               \
                             \
    bf16x8 v2a = LDF(vb + vo0), v2b = LDF(vb + vo1), v2c = LDF(vb + 4096 + vo0), v2d = LDF(vb + 4096 + vo1);       \
    NA = MFMA32(Kb, Qb, zero16);                                                                         \
    NB = MFMA32(Kb, Qb, zero16);                                                                         \
    NA = MFMA32(k0a, Qf[0], NA);                                                                         \
    NB = MFMA32(k0b, Qf[0], NB);                                                                         \
    NA = MFMA32(k0c, Qf[1], NA);                                                                         \
    NB = MFMA32(k0d, Qf[1], NB);                                                                         \
    float ps_ = 0.f;                                                                                     \
    _Pragma("unroll") for (int i = 0; i < 8; ++i) { CA[i] = __builtin_amdgcn_exp2f(CA[i]); ps_ += CA[i]; } \
    GRP(6, 3)                                                                                            \
                                    \
    bf16x8 v3a = LDF(vb + 8192 + vo0), v3b = LDF(vb + 8192 + vo1), v3c = LDF(vb + 12288 + vo0), v3d = LDF(vb + 12288 + vo1);   \
    NA = MFMA32(g1a, Qf[2], NA);                                                                         \
    NB = MFMA32(g1b, Qf[2], NB);                                                                         \
    NA = MFMA32(g1c, Qf[3], NA);                                                                         \
    NB = MFMA32(g1d, Qf[3], NB);                                                                         \
    _Pragma("unroll") for (int i = 8; i < 16; ++i) { CA[i] = __builtin_amdgcn_exp2f(CA[i]); ps_ += CA[i]; } \
    bf16x8 P00 = mk8(pack2(CA[0], CA[1]), pack2(CA[2], CA[3]), pack2(CA[4], CA[5]), pack2(CA[6], CA[7]));        \
    bf16x8 P01 = mk8(pack2(CA[8], CA[9]), pack2(CA[10], CA[11]), pack2(CA[12], CA[13]), pack2(CA[14], CA[15]));  \
    GRP(4, 6)                                                                                            \
                \
    bf16x8 v4a = LDF(vb + vo2), v4b = LDF(vb + vo3), v4c = LDF(vb + 4096 + vo2), v4d = LDF(vb + 4096 + vo3); \
    O[0] = MFMA32(v2a, P00, O[0]);                                                                       \
    O[0] = MFMA32(v2b, P01, O[0]);                                                                       \
    O[1] = MFMA32(v2c, P00, O[1]);                                                                       \
    O[1] = MFMA32(v2d, P01, O[1]);                                                                       \
    _Pragma("unroll") for (int i = 0; i < 8; ++i) { CB[i] = __builtin_amdgcn_exp2f(CB[i]); ps_ += CB[i]; } \
    int tni_ = max(FB(NA[0]), FB(NB[0]));                                                                \
    PMAX4(NA, NB, 0, tni_)                                                                                \
    GRP(4, 5)                                                                                            \
          \
    bf16x8 v5a = LDF(vb + 8192 + vo2), v5b = LDF(vb + 8192 + vo3), v5c = LDF(vb + 12288 + vo2), v5d = LDF(vb + 12288 + vo3); \
    O[2] = MFMA32(v3a, P00, O[2]);                                                                       \
    O[2] = MFMA32(v3b, P01, O[2]);                                                                       \
    O[3] = MFMA32(v3c, P00, O[3]);                                                                       \
    O[3] = MFMA32(v3d, P01, O[3]);                                                                       \
    _Pragma("unroll") for (int i = 8; i < 16; ++i) { CB[i] = __builtin_amdgcn_exp2f(CB[i]); ps_ += CB[i]; } \
    bf16x8 P10 = mk8(pack2(CB[0], CB[1]), pack2(CB[2], CB[3]), pack2(CB[4], CB[5]), pack2(CB[6], CB[7]));        \
    bf16x8 P11 = mk8(pack2(CB[8], CB[9]), pack2(CB[10], CB[11]), pack2(CB[12], CB[13]), pack2(CB[14], CB[15]));  \
    PMAX4(NA, NB, 4, tni_)                                                                               \
    GRP(4, 7)                                                                                            \
                              \
    O[0] = MFMA32(v4a, P10, O[0]);                                                                       \
    O[0] = MFMA32(v4b, P11, O[0]);                                                                       \
    O[1] = MFMA32(v4c, P10, O[1]);                                                                       \
    O[1] = MFMA32(v4d, P11, O[1]);                                                                       \
    PMAX4(NA, NB, 8, tni_)                                                                               \
    GRP(4, 1)                                                                                            \
                                                  \
    O[2] = MFMA32(v5a, P10, O[2]);                                                                       \
    O[2] = MFMA32(v5b, P11, O[2]);                                                                       \
    O[3] = MFMA32(v5c, P10, O[3]);                                                                       \
    O[3] = MFMA32(v5d, P11, O[3]);                                                                       \
    PMAX4(NA, NB, 12, tni_)                                                                              \
    __builtin_amdgcn_sched_barrier(0);                                                                   \
    lrun += ps_;                                                                                         \
       \
                      \
    if (kt_ + 1 < nkt && __any(__int_as_float(tni_) > THR)) {                                            \
      tni_ = max(tni_, __shfl_xor(tni_, 32));                                                            \
      const float tn_ = __int_as_float(tni_);                                                             \
      const float mnew = blo(pack2(mrun + fmaxf(tn_, 0.f), 0.f));                                        \
      const float dlt = mnew - mrun;                                                                     \
      const float alpha = __builtin_amdgcn_exp2f(-dlt);                                                  \
      mrun = mnew;                                                                                       \
      Qb = mk8(h == 0 ? (pack2(-mrun, 0.f) & 0xffffu) : 0u, 0u, 0u, 0u);                                 \
      lrun *= alpha;                                                                                     \
      _Pragma("unroll") for (int i = 0; i < 16; ++i) { NA[i] -= dlt; NB[i] -= dlt; }                     \
      _Pragma("unroll") for (int e = 0; e < 4; ++e)                                                      \
        _Pragma("unroll") for (int i = 0; i < 16; ++i) O[e][i] *= alpha;                                 \
    }                                                                                                    \
    if ((kt_ & 1) == 0) { asm volatile("s_waitcnt vmcnt(0)" ::: "memory"); __syncthreads(); }           \
    {                                                                                                    \
      const unsigned char* kn = kbase + ((kt_ + 2) & 3) * 16384;                                         \
      k0a = LDF(kn + ko0);                                                                                     \
      k0b = LDF(kn + 8192 + ko0);                                                                          \
      k0c = LDF(kn + ko1);                                                                                \
      k0d = LDF(kn + 8192 + ko1);                                                                     \
      g1a = LDF(kn + ko2);                                                                               \
      g1b = LDF(kn + 8192 + ko2);                                                                        \
      g1c = LDF(kn + ko3);                                                                               \
      g1d = LDF(kn + 8192 + ko3);                                                                        \
    }                                                                                                    \
  }
  bf16x8 k0a, k0b, k0c, k0d, g1a, g1b, g1c, g1d;
  f32x16 Sa0, Sa1, Sb0, Sb1;
  KGLDS(0, 0);
  VGLDS(0, 0);
  KGLDS(1, 1);
  VGLDS(1, 1);
  KGLDS(2, 2);
  asm volatile("s_waitcnt vmcnt(0)" ::: "memory");
  __syncthreads();
  SCOMP(0, Sa0, Sa1);
  {
    float t0;
    TILEMAX(Sa0, Sa1, t0);
    mrun = blo(pack2(t0, 0.f));
    Qb = mk8(h == 0 ? (pack2(-mrun, 0.f) & 0xffffu) : 0u, 0u, 0u, 0u);
#pragma unroll
    for (int i = 0; i < 16; ++i) { Sa0[i] -= mrun; Sa1[i] -= mrun; }
  }
  {
    const unsigned char* kn = kbase + 16384;
    k0a = LDF(kn + ko0);
    k0b = LDF(kn + 8192 + ko0);
    k0c = LDF(kn + ko1);
    k0d = LDF(kn + 8192 + ko1);
    g1a = LDF(kn + ko2);
    g1b = LDF(kn + 8192 + ko2);
    g1c = LDF(kn + ko3);
    g1d = LDF(kn + 8192 + ko3);
  }
  for (int kt = 0; kt < nkt; kt += 2) {
    ASTEP(kt, Sa0, Sa1, Sb0, Sb1);
    ASTEP(kt + 1, Sb0, Sb1, Sa0, Sa1);
  }
  __syncthreads();
#undef ASTEP
#undef GRP
#undef PMAX4
#undef FB
#undef LDF
#undef TILEMAX
#undef SCOMP
#undef KGLDS
#undef VGLDS
  lrun += __shfl_xor(lrun, 32);
  const float inv = 1.f / lrun;
  float* sX = (float*)(smem + 71680);
  unsigned char* sO = smem;
  if (m == 1) {
    const float sc = lam * inv;
#pragma unroll
    for (int e = 0; e < 4; ++e)
#pragma unroll
      for (int i = 0; i < 16; ++i) sX[(qs * 64 + e * 16 + i) * 64 + lane] = O[e][i] * sc;
  }
  __syncthreads();
  if (m == 0) {
    float ssq = 0.f;
#pragma unroll
    for (int e = 0; e < 4; ++e)
#pragma unroll
      for (int i = 0; i < 16; ++i) {
        float o = O[e][i] * inv - sX[(qs * 64 + e * 16 + i) * 64 + lane];
        O[e][i] = o;
        ssq += o * o;
      }
    ssq += __shfl_xor(ssq, 32);
    const float rstd = rsqrtf(ssq * (1.f / 128.f) + EPS) * (1.f - lam_init);
    const float* sg = p.subln_g + L * 128;
#pragma unroll
    for (int e = 0; e < 4; ++e)
#pragma unroll
      for (int g = 0; g < 4; ++g) {
        int e0 = e * 32 + 8 * g + 4 * h;
        float4 gg = *(const float4*)(sg + e0);
        uint2 v = {pack2(O[e][4 * g + 0] * rstd * gg.x, O[e][4 * g + 1] * rstd * gg.y),
                   pack2(O[e][4 * g + 2] * rstd * gg.z, O[e][4 * g + 3] * rstd * gg.w)};
        *(uint2*)(sO + (qs * 32 + r) * 272 + e0 * 2) = v;
      }
  }
  __syncthreads();
  if (m == 0) {
#pragma unroll
    for (int j = 0; j < 8; ++j) {
      int c = lane + 64 * j, row = c >> 4, ch = c & 15;
      uint4 v = *(const uint4*)(sO + (qs * 32 + row) * 272 + ch * 16);
      *(uint4*)(mixin + (size_t)(qrow0 + qs * 32 + row) * 1024 + hh * 128 + ch * 8) = v;
    }
  }
  __syncthreads();
}

#pragma float_control(pop)
DI int ssd_rowbase(int b, int sc) { return (sc < 2) ? (TLAT + b * 256 + sc * 128) : (b * SEQ + (sc - 2) * 128); }

DI void chunk_scan(const float* dtb, int rowbase, int col, float A, int lane, float& d0, float& d1, float& a0, float& a1,
                   float& c0, float& c1, float& total) {
  d0 = dtb[(size_t)(rowbase + 2 * lane) * 16 + col];
  d1 = dtb[(size_t)(rowbase + 2 * lane + 1) * 16 + col];
  a0 = d0 * A;
  a1 = d1 * A;
  float s = a0 + a1;
#pragma unroll
  for (int off = 1; off < 64; off <<= 1) {
    float t = __shfl_up(s, off);
    if (lane >= off) s += t;
  }
  c1 = s;
  c0 = s - a1;
  total = __shfl(s, 63);
}

DI void ssd_s1_item(const Params& p, int L, int item, unsigned char* smem) {
  const int tid = tid_(), lane = tid & 63, w = tid >> 6, r = lane & 31, h = lane >> 5;
  const int g = item & 1, bs = item >> 1, sc = bs % 130, b = bs / 130;
  const int rowbase = ssd_rowbase(b, sc);
  const u16* xbcT = (const u16*)(p.ws + OFF_R5);
  const float* dtb = (const float*)(p.ws + OFF_DTB);
  u16* Sst = (u16*)(p.ws + OFF_R1);
  float* dac = (float*)(p.ws + OFF_DAC);
  unsigned char* sXT = smem;
  unsigned char* sBT = smem + 69632;
  float* sWt = (float*)(smem + 69632 + 34816);
#pragma unroll
  for (int j = 0; j < 8; ++j) {
    int c = tid + 512 * j, ch = c >> 4, t8 = c & 15;
    *(uint4*)(sXT + ch * 272 + t8 * 16) = *(const uint4*)(xbcT + (size_t)(g * 256 + ch) * TT + rowbase + t8 * 8);
  }
#pragma unroll
  for (int j = 0; j < 4; ++j) {
    int c = tid + 512 * j, ch = c >> 4, t8 = c & 15;
    *(uint4*)(sBT + ch * 272 + t8 * 16) = *(const uint4*)(xbcT + (size_t)(512 + g * 128 + ch) * TT + rowbase + t8 * 8);
  }
  const int hd = w >> 1, dir = w & 1, H = g * 4 + hd;
  {
    const float A = -expf(p.a_log[L * 16 + dir * 8 + H]);
    float d0, d1, a0, a1, c0, c1, total;
    chunk_scan(dtb, rowbase, dir * 8 + H, A, lane, d0, d1, a0, a1, c0, c1, total);
    float w0, w1;
    if (dir == 0) { w0 = d0 * __expf(total - c0); w1 = d1 * __expf(total - c1); }
    else { w0 = d0 * __expf(c0 - a0); w1 = d1 * __expf(c1 - a1); }
    sWt[w * 128 + 2 * lane] = w0;
    sWt[w * 128 + 2 * lane + 1] = w1;
    if (lane == 0) dac[((b * 2 + dir) * 130 + sc) * 8 + H] = __expf(total);
  }
  __syncthreads();
  f32x16 acc[2][4];
#pragma unroll
  for (int a = 0; a < 2; ++a)
#pragma unroll
    for (int n = 0; n < 4; ++n)
#pragma unroll
      for (int i = 0; i < 16; ++i) acc[a][n][i] = 0.f;
#pragma unroll 2
  for (int ks = 0; ks < 8; ++ks) {
    float4 wa = *(const float4*)(sWt + w * 128 + ks * 16 + h * 8), wb = *(const float4*)(sWt + w * 128 + ks * 16 + h * 8 + 4);
    bf16x8 af[2], bfr[4];
#pragma unroll
    for (int a = 0; a < 2; ++a) {
      uint4 u = *(const uint4*)(sXT + (hd * 64 + a * 32 + r) * 272 + ks * 32 + h * 16);
      af[a] = mk8(pack2(blo(u.x) * wa.x, bhi(u.x) * wa.y), pack2(blo(u.y) * wa.z, bhi(u.y) * wa.w),
                  pack2(blo(u.z) * wb.x, bhi(u.z) * wb.y), pack2(blo(u.w) * wb.z, bhi(u.w) * wb.w));
    }
#pragma unroll
    for (int n = 0; n < 4; ++n) bfr[n] = *(const bf16x8*)(sBT + (n * 32 + r) * 272 + ks * 32 + h * 16);
#pragma unroll
    for (int a = 0; a < 2; ++a)
#pragma unroll
      for (int n = 0; n < 4; ++n) acc[a][n] = MFMA32(af[a], bfr[n], acc[a][n]);
  }
  u16* dst = Sst + ((size_t)((b * 2 + dir) * 130 + sc) * 8 + H) * 8192;
#pragma unroll
  for (int a = 0; a < 2; ++a)
#pragma unroll
    for (int n = 0; n < 4; ++n)
#pragma unroll
      for (int i = 0; i < 16; ++i)
        dst[(a * 32 + crow(i, h)) * 128 + n * 32 + r] = (u16)(pack2(acc[a][n][i], 0.f) & 0xffffu);
  __syncthreads();
}

DI void ssd_s2_phase(const Params& p) {
  const u16* Sst = (const u16*)(p.ws + OFF_R1);
  u16* Hb = (u16*)(p.ws + OFF_HB);
  const float* dac = (const float*)(p.ws + OFF_DAC);
  const int nthreads = gridDim.x * 512;
  for (int gid = bid_() * 512 + threadIdx.x; gid < 131072; gid += nthreads) {
    const int bd = gid >> 15, e2 = gid & 32767, dir = bd & 1;
    const int head = e2 >> 12;
    float2 hc = make_float2(0.f, 0.f);
#pragma unroll 1
    for (int s0 = 0; s0 < 130; s0 += 10) {
      float2 tmp[10];
      float dd[10];
#pragma unroll
      for (int q = 0; q < 10; ++q) {
        int step = s0 + q;
        int sc = (dir == 0) ? step : (step < 2 ? 1 - step : 131 - step);
        {
          unsigned u_ = *(const unsigned*)(Sst + ((size_t)(bd * 130 + sc) * 8) * 8192 + 2 * e2);
          tmp[q] = make_float2(blo(u_), bhi(u_));
        }
        dd[q] = dac[(bd * 130 + sc) * 8 + head];
      }
#pragma unroll
      for (int q = 0; q < 10; ++q) {
        int step = s0 + q;
        int sc = (dir == 0) ? step : (step < 2 ? 1 - step : 131 - step);
        *(unsigned*)(Hb + ((size_t)(bd * 130 + sc) * 8) * 8192 + 2 * e2) = pack2(hc.x, hc.y);
        hc.x = hc.x * dd[q] + tmp[q].x;
        hc.y = hc.y * dd[q] + tmp[q].y;
      }
    }
  }
}

DI void ssd_s3_item(const Params& p, int L, int item, unsigned char* smem) {
  const int tid = tid_(), lane = tid & 63, w = tid >> 6, r = lane & 31, h = lane >> 5;
  const int g = item & 1, bs = item >> 1, sc = bs % 130, b = bs / 130;
  const int rowbase = ssd_rowbase(b, sc);
  const u16* xbcc = (const u16*)(p.ws + OFF_R0);
  const u16* xbcT = (const u16*)(p.ws + OFF_R5);
  const u16* zb = (const u16*)(p.ws + OFF_R2 + UB / 2);
  u16* ubuf = (u16*)(p.ws + OFF_R2);
  const float* dtb = (const float*)(p.ws + OFF_DTB);
  const u16* Hb = (const u16*)(p.ws + OFF_HB);
  unsigned char* sC = smem;
  unsigned char* sB = smem + 34816;
  unsigned char* sXT = smem + 69632;
  float* sCum = (float*)(smem + 139264);
  float* sDt = sCum + 1024;
#pragma unroll
  for (int j = 0; j < 4; ++j) {
    int c = tid + 512 * j, t = c >> 4, n8 = c & 15;
    *(uint4*)(sC + t * 272 + n8 * 16) = *(const uint4*)(xbcc + (size_t)(rowbase + t) * 1024 + 768 + g * 128 + n8 * 8);
    *(uint4*)(sB + t * 272 + n8 * 16) = *(const uint4*)(xbcc + (size_t)(rowbase + t) * 1024 + 512 + g * 128 + n8 * 8);
  }
#pragma unroll
  for (int j = 0; j < 8; ++j) {
    int c = tid + 512 * j, ch = c >> 4, t8 = c & 15;
    *(uint4*)(sXT + ch * 272 + t8 * 16) = *(const uint4*)(xbcT + (size_t)(g * 256 + ch) * TT + rowbase + t8 * 8);
  }
  {
    const int hd = w >> 1, dir = w & 1, H = g * 4 + hd;
    const float A = -expf(p.a_log[L * 16 + dir * 8 + H]);
    float d0, d1, a0, a1, c0, c1, total;
    chunk_scan(dtb, rowbase, dir * 8 + H, A, lane, d0, d1, a0, a1, c0, c1, total);
    float* cu = sCum + (dir * 4 + hd) * 128;
    float* dd = sDt + (dir * 4 + hd) * 128;
    if (dir == 0) { cu[2 * lane] = c0; cu[2 * lane + 1] = c1; }
    else { cu[2 * lane] = total - c0 + a0; cu[2 * lane + 1] = total - c1 + a1; }
    dd[2 * lane] = d0;
    dd[2 * lane + 1] = d1;
  }
  __syncthreads();
  {
    const int ti = w >> 1, tj0 = 2 * (w & 1);
    f32x16 cb[2];
#pragma unroll
    for (int q = 0; q < 2; ++q)
#pragma unroll
      for (int i = 0; i < 16; ++i) cb[q][i] = 0.f;
#pragma unroll
    for (int ks = 0; ks < 8; ++ks) {
      bf16x8 a = *(const bf16x8*)(sC + (ti * 32 + r) * 272 + ks * 32 + h * 16);
#pragma unroll
      for (int q = 0; q < 2; ++q) {
        bf16x8 bb = *(const bf16x8*)(sB + ((tj0 + q) * 32 + r) * 272 + ks * 32 + h * 16);
        cb[q] = MFMA32(a, bb, cb[q]);
      }
    }
    __syncthreads();
#pragma unroll
    for (int q = 0; q < 2; ++q)
#pragma unroll
      for (int i = 0; i < 16; ++i)
        *(u16*)(sB + (ti * 32 + crow(i, h)) * 272 + ((tj0 + q) * 32 + r) * 2) = (u16)(pack2(cb[q][i], 0.f) & 0xffffu);
    __syncthreads();
  }
  const int hd = w >> 1, th = w & 1, H = g * 4 + hd;
  const float* cuF = sCum + (0 * 4 + hd) * 128;
  const float* cuB = sCum + (1 * 4 + hd) * 128;
  const float* dtF = sDt + (0 * 4 + hd) * 128;
  const float* dtB = sDt + (1 * 4 + hd) * 128;
  f32x16 y[2][2];
#pragma unroll
  for (int dir = 0; dir < 2; ++dir) {
    f32x16 acc[2][2];
#pragma unroll
    for (int a = 0; a < 2; ++a)
#pragma unroll
      for (int n = 0; n < 2; ++n)
#pragma unroll
        for (int i = 0; i < 16; ++i) acc[a][n][i] = 0.f;
    const u16* hp = Hb + ((size_t)((b * 2 + dir) * 130 + sc) * 8 + H) * 8192 + r * 128 + h * 8;
    bf16x8 hf[8][2];
#pragma unroll
    for (int ks = 0; ks < 8; ++ks)
#pragma unroll
      for (int n = 0; n < 2; ++n) hf[ks][n] = *(const bf16x8*)(hp + n * 32 * 128 + ks * 16);
#pragma unroll
    for (int ks = 0; ks < 8; ++ks) {
      bf16x8 af[2];
#pragma unroll
      for (int a = 0; a < 2; ++a) af[a] = *(const bf16x8*)(sC + (th * 64 + a * 32 + r) * 272 + ks * 32 + h * 16);
#pragma unroll
      for (int a = 0; a < 2; ++a)
#pragma unroll
        for (int n = 0; n < 2; ++n) acc[a][n] = MFMA32(af[a], hf[ks][n], acc[a][n]);
    }
    const float* cu = (dir == 0) ? cuF : cuB;
#pragma unroll
    for (int a = 0; a < 2; ++a)
#pragma unroll
      for (int i = 0; i < 16; ++i) {
        float e = __expf(cu[th * 64 + a * 32 + crow(i, h)]);
#pragma unroll
        for (int n = 0; n < 2; ++n) {
          if (dir == 0) y[a][n][i] = acc[a][n][i] * e;
          else y[a][n][i] += acc[a][n][i] * e;
        }
      }
  }
#pragma unroll 1
  for (int ks = 0; ks < 8; ++ks) {
    const int s0 = ks * 16 + h * 8;
    float cFs[8], cBs[8], dFs[8], dBs[8];
    {
      float4 v0, v1;
      v0 = *(const float4*)(cuF + s0); v1 = *(const float4*)(cuF + s0 + 4);
      cFs[0] = v0.x; cFs[1] = v0.y; cFs[2] = v0.z; cFs[3] = v0.w; cFs[4] = v1.x; cFs[5] = v1.y; cFs[6] = v1.z; cFs[7] = v1.w;
      v0 = *(const float4*)(cuB + s0); v1 = *(const float4*)(cuB + s0 + 4);
      cBs[0] = v0.x; cBs[1] = v0.y; cBs[2] = v0.z; cBs[3] = v0.w; cBs[4] = v1.x; cBs[5] = v1.y; cBs[6] = v1.z; cBs[7] = v1.w;
      v0 = *(const float4*)(dtF + s0); v1 = *(const float4*)(dtF + s0 + 4);
      dFs[0] = v0.x; dFs[1] = v0.y; dFs[2] = v0.z; dFs[3] = v0.w; dFs[4] = v1.x; dFs[5] = v1.y; dFs[6] = v1.z; dFs[7] = v1.w;
      v0 = *(const float4*)(dtB + s0); v1 = *(const float4*)(dtB + s0 + 4);
      dBs[0] = v0.x; dBs[1] = v0.y; dBs[2] = v0.z; dBs[3] = v0.w; dBs[4] = v1.x; dBs[5] = v1.y; dBs[6] = v1.z; dBs[7] = v1.w;
    }
    bf16x8 af[2], bfr[2];
#pragma unroll
    for (int a = 0; a < 2; ++a) {
      const int t = th * 64 + a * 32 + r;
      const float cFt = cuF[t], cBt = cuB[t];
      uint4 u = *(const uint4*)(sB + t * 272 + s0 * 2);
      float cbv[8] = {blo(u.x), bhi(u.x), blo(u.y), bhi(u.y), blo(u.z), bhi(u.z), blo(u.w), bhi(u.w)};
      float gv[8];
#pragma unroll
      for (int j = 0; j < 8; ++j) {
        const int s = s0 + j;
        float mf = (s <= t) ? __expf(cFt - cFs[j]) * dFs[j] : 0.f;
        float mb = (s >= t) ? __expf(cBt - cBs[j]) * dBs[j] : 0.f;
        gv[j] = cbv[j] * (mf + mb);
      }
      af[a] = mk8(pack2(gv[0], gv[1]), pack2(gv[2], gv[3]), pack2(gv[4], gv[5]), pack2(gv[6], gv[7]));
    }
#pragma unroll
    for (int n = 0; n < 2; ++n) bfr[n] = *(const bf16x8*)(sXT + (hd * 64 + n * 32 + r) * 272 + ks * 32 + h * 16);
#pragma unroll
    for (int a = 0; a < 2; ++a)
#pragma unroll
      for (int n = 0; n < 2; ++n) y[a][n] = MFMA32(af[a], bfr[n], y[a][n]);
  }
  const float Dh = p.d_skip[L * 8 + H];
#pragma unroll
  for (int a = 0; a < 2; ++a)
#pragma unroll
    for (int n = 0; n < 2; ++n)
#pragma unroll
      for (int i = 0; i < 16; ++i) {
        const int t = th * 64 + a * 32 + crow(i, h), pp = n * 32 + r;
        float xv = bf2f(*(const u16*)(sXT + (hd * 64 + pp) * 272 + t * 2));
        float uv = y[a][n][i] + Dh * xv;
        ubuf[(size_t)(rowbase + t) * 512 + H * 64 + pp] = (u16)(pack2(uv, 0.f) & 0xffffu);
      }
  __syncthreads();
}

DI void gnorm_phase(const Params& p, int L) {
  const int tid = tid_(), lane = tid & 63, w = tid >> 6;
  const u16* ubuf = (const u16*)(p.ws + OFF_R2);
  const u16* zb = (const u16*)(p.ws + OFF_R2 + UB / 2);
  u16* mixin = (u16*)(p.ws + OFF_R4);
  const float* g = p.ssd_norm_g + L * 512 + lane * 8;
  const int nb = gridDim.x;
  const int nrows = (L == 1) ? TLAT : TT;
  for (int row = bid_() * 8 + w; row < nrows; row += nb * 8) {
    uint4 u = *(const uint4*)(ubuf + (size_t)row * 512 + lane * 8);
    uint4 zz = *(const uint4*)(zb + (size_t)row * 512 + lane * 8);
    float v[8] = {blo(u.x) * silu_f(blo(zz.x)), bhi(u.x) * silu_f(bhi(zz.x)), blo(u.y) * silu_f(blo(zz.y)),
                  bhi(u.y) * silu_f(bhi(zz.y)), blo(u.z) * silu_f(blo(zz.z)), bhi(u.z) * silu_f(bhi(zz.z)),
                  blo(u.w) * silu_f(blo(zz.w)), bhi(u.w) * silu_f(bhi(zz.w))};
    float ssq = 0.f;
#pragma unroll
    for (int e = 0; e < 8; ++e) ssq += v[e] * v[e];
    ssq = wave_sum(ssq);
    const float rstd = rsqrtf(ssq * (1.f / 512.f) + EPS);
    uint4 o = {pack2(v[0] * rstd * g[0], v[1] * rstd * g[1]), pack2(v[2] * rstd * g[2], v[3] * rstd * g[3]),
               pack2(v[4] * rstd * g[4], v[5] * rstd * g[5]), pack2(v[6] * rstd * g[6], v[7] * rstd * g[7])};
    *(uint4*)(mixin + (size_t)row * 1024 + 512 + lane * 8) = o;
  }
}

#define XB_TMO 128
#define XB_XCNT(j) (256 + 64 * (j))
#define XB_XSUB(j) (1280 + 64 * (j))
#define XB_XGEN(j) (2304 + 64 * (j))
#define XB_TOP 3328
#define XB_TOPGEN 3392
#define XCD_BAR_WORDS 3456
#define XB_SPIN_CAP (1u << 20)
#define LAS __attribute__((address_space(3)))
DI unsigned xb_ld(unsigned* p) { return __hip_atomic_load(p, __ATOMIC_RELAXED, __HIP_MEMORY_SCOPE_AGENT); }
DI unsigned xb_add(unsigned* p, unsigned v) { return __hip_atomic_fetch_add(p, v, __ATOMIC_RELAXED, __HIP_MEMORY_SCOPE_AGENT); }
DI unsigned xb_xcc_id() { return (unsigned)__builtin_amdgcn_s_getreg((3 << 11) | 20) & 0xFu; }
#define XB_SPIN(cond, bar)                                                                              \
  do {                                                                                                  \
    unsigned _sp = 0;                                                                                   \
    while (cond) {                                                                                      \
      __builtin_amdgcn_s_sleep(1);                                                                      \
      if ((++_sp & 255u) == 0u) {                                                                       \
        if (xb_ld(&(bar)[XB_TMO])) break;                                                               \
        if (_sp > XB_SPIN_CAP) { atomicAdd(&(bar)[XB_TMO], 1u); break; }                                \
      }                                                                                                 \
    }                                                                                                   \
  } while (0)
struct XcdBarrier {
  unsigned* bar;
  unsigned x;
  volatile LAS unsigned* st;
};
DI XcdBarrier xcd_barrier_post(unsigned* bar, volatile LAS unsigned* st) {
  XcdBarrier b;
  b.bar = bar;
  b.x = xb_xcc_id();
  b.st = st;
  if (threadIdx.x == 0) (void)xb_add(&bar[XB_XCNT(b.x)], 1u);
  return b;
}
DI void xcd_barrier_complete(unsigned* bar, unsigned x, unsigned& nloc, unsigned& nx) {
  const unsigned G = gridDim.x * gridDim.y * gridDim.z;
  unsigned sum, cnt, mine, sp = 0u;
  for (;;) {
    sum = 0u; cnt = 0u; mine = 0u;
#pragma unroll
    for (unsigned j = 0; j < 16; ++j) {
      const unsigned c = xb_ld(&bar[XB_XCNT(j)]);
      sum += c;
      cnt += (c > 0u) ? 1u : 0u;
      mine = (j == x) ? c : mine;
    }
    if (sum == G) break;
    __builtin_amdgcn_s_sleep(1);
    if ((++sp & 255u) == 0u) {
      if (xb_ld(&bar[XB_TMO])) break;
      if (sp > XB_SPIN_CAP) { atomicAdd(&bar[XB_TMO], 1u); break; }
    }
  }
  nloc = mine > 0u ? mine : 1u;
  nx = cnt > 0u ? cnt : 1u;
}
DI void xcd_barrier(const XcdBarrier& b) {
  asm volatile("s_waitcnt vmcnt(0)" ::: "memory");
  __syncthreads();
  if (threadIdx.x == 0) {
    unsigned* bar = b.bar;
    __builtin_amdgcn_s_waitcnt(0);
    unsigned nloc = b.st[0], nx = b.st[1];
    if (nloc == 0u) { xcd_barrier_complete(bar, b.x, nloc, nx); b.st[0] = nloc; b.st[1] = nx; }
    const unsigned old = xb_add(&bar[XB_XSUB(b.x)], 1u);
    const unsigned gen = old / nloc;
    if (old + 1u == (gen + 1u) * nloc) {
      __builtin_amdgcn_fence(__ATOMIC_RELEASE, "agent");
      asm volatile("s_waitcnt vmcnt(0)" ::: "memory");
      const unsigned og = xb_add(&bar[XB_TOP], 1u);
      const unsigned tg = og / nx;
      if (og + 1u == (tg + 1u) * nx) xb_add(&bar[XB_TOPGEN], 1u);
      else XB_SPIN(xb_ld(&bar[XB_TOPGEN]) == tg, bar);
      __builtin_amdgcn_fence(__ATOMIC_ACQUIRE, "agent");
      xb_add(&bar[XB_XGEN(b.x)], 1u);
      asm volatile("s_waitcnt vmcnt(0)" ::: "memory");
    } else {
      XB_SPIN(xb_ld(&bar[XB_XGEN(b.x)]) == gen, bar);
      __builtin_amdgcn_fence(__ATOMIC_ACQUIRE, "agent");
      asm volatile("s_waitcnt vmcnt(0)" ::: "memory");
    }
  }
  __syncthreads();
}

constexpr int NPHASE = 2 + 11 * 2;

template <int s>
DI void layer_phase(const Params& p, int L, unsigned char* smem) {
  const int nb = gridDim.x, vb = vblock();
  EpiArgs ea;
  ea.dst = nullptr; ea.ldd = 0;
  ea.qk = (u16*)(p.ws + OFF_R1); ea.vT = (u16*)(p.ws + OFF_R2); ea.zb = (u16*)(p.ws + OFF_R2 + UB / 2);
  ea.xraw = (u16*)(p.ws + OFF_R3); ea.rope = (const float2*)(p.ws + OFF_ROPE);
  switch (s) {
    case 0:
      gemm_phase<EPI_INPROJ, 4>((const u16*)(p.ws + OFF_R0), 1024, (const u16*)(p.ws + OFF_WIN) + (size_t)L * 3072 * 1024, 1024,
                                1024, 12, 128, 0, ea, smem);
      gemm_phase<EPI_INPROJ, 1>((const u16*)(p.ws + OFF_R0), 1024, (const u16*)(p.ws + OFF_WIN) + (size_t)L * 3072 * 1024, 1024,
                                1024, 12, 8, TLAT, ea, smem);
      break;
    case 1:
      for (int it = vb; it < 1040; it += nb) conv_item(p, L, it, smem);
      for (int u = vb; u < (L == 0 ? 1040 : 1024); u += nb) attn_unit(p, L, u, smem);
      break;
    case 2:
      for (int it = vb; it < 520; it += nb) ssd_s1_item(p, L, it, smem);
      break;
    case 3:
      ssd_s2_phase(p);
      break;
    case 4:
      if (L == 1) {
        for (int it = vb; it < 512; it += nb) {
          const int q = it >> 1;
          ssd_s3_item(p, L, (((q >> 7) * 130 + 2 + (q & 127)) << 1) | (it & 1), smem);
        }
      } else {
        for (int it = vb; it < 520; it += nb) ssd_s3_item(p, L, it, smem);
      }
      break;
    case 5:
      gnorm_phase(p, L);
      break;
    case 6:
      ea.dst = (u16*)(p.ws + OFF_R1); ea.ldd = 1024;
      gemm_phase<EPI_PLAIN, 4>((const u16*)(p.ws + OFF_R4), 1024, (const u16*)(p.ws + OFF_WOUT) + (size_t)L * 1024 * 1024, 1024,
                               1024, 4, 128, 0, ea, smem);
      if (L == 0)
        gemm_phase<EPI_PLAIN, 1>((const u16*)(p.ws + OFF_R4), 1024, (const u16*)(p.ws + OFF_WOUT) + (size_t)L * 1024 * 1024,
                                 1024, 1024, 4, 8, TLAT, ea, smem);
      break;
    case 7:
      norm_phase<1>(p, L, smem);
      break;
    case 8:
      ea.dst = (u16*)(p.ws + OFF_R3); ea.ldd = DFF;
      gemm_phase<EPI_FFNIN, 4>((const u16*)(p.ws + OFF_R0), 1024, (const u16*)(p.ws + OFF_WFI) + (size_t)L * 5632 * 1024, 1024,
                               1024, 22, 128, 0, ea, smem);
      if (L == 0)
        gemm_phase<EPI_FFNIN, 1>((const u16*)(p.ws + OFF_R0), 1024, (const u16*)(p.ws + OFF_WFI) + (size_t)L * 5632 * 1024,
                                 1024, 1024, 22, 8, TLAT, ea, smem);
      break;
    case 9:
      ea.dst = (u16*)(p.ws + OFF_R1); ea.ldd = 1024;
      gemm_phase<EPI_PLAIN, 4>((const u16*)(p.ws + OFF_R3), DFF, (const u16*)(p.ws + OFF_WFO) + (size_t)L * 1024 * DFF, DFF, DFF,
                               4, 128, 0, ea, smem);
      if (L == 0)
        gemm_phase<EPI_PLAIN, 1>((const u16*)(p.ws + OFF_R3), DFF, (const u16*)(p.ws + OFF_WFO) + (size_t)L * 1024 * DFF, DFF,
                                 DFF, 4, 8, TLAT, ea, smem);
      break;
    case 10:
      norm_phase<2>(p, L, smem);
      break;
  }
}

DI void run_phase(const Params& p, int ph, unsigned char* smem) {
  if (ph == 0) { prologue_phase(p, smem); return; }
  if (ph == 1) { norm_phase<0>(p, 0, smem); return; }
  const int L = (ph - 2) / 11, s = (ph - 2) % 11;
  switch (s) {
    case 0: layer_phase<0>(p, L, smem); break;
    case 1: layer_phase<1>(p, L, smem); break;
    case 2: layer_phase<2>(p, L, smem); break;
    case 3: layer_phase<3>(p, L, smem); break;
    case 4: layer_phase<4>(p, L, smem); break;
    case 5: layer_phase<5>(p, L, smem); break;
    case 6: layer_phase<6>(p, L, smem); break;
    case 7: layer_phase<7>(p, L, smem); break;
    case 8: layer_phase<8>(p, L, smem); break;
    case 9: layer_phase<9>(p, L, smem); break;
    case 10: layer_phase<10>(p, L, smem); break;
  }
}

#ifdef PHASE_TEST
template <int PH>
__global__ void __launch_bounds__(512) tk(Params p, int L) {
  __shared__ __attribute__((aligned(16))) unsigned char smem[SMEM_BYTES];
  if (PH == 0) prologue_phase(p, smem);
  else if (PH == 1) norm_phase<0>(p, 0, smem);
  else layer_phase<(PH >= 2 ? PH - 2 : 0)>(p, L, smem);
}
template __global__ void tk<0>(Params, int);
template __global__ void tk<1>(Params, int);
template __global__ void tk<2>(Params, int);
template __global__ void tk<3>(Params, int);
template __global__ void tk<4>(Params, int);
template __global__ void tk<5>(Params, int);
template __global__ void tk<6>(Params, int);
template __global__ void tk<7>(Params, int);
template __global__ void tk<8>(Params, int);
template __global__ void tk<9>(Params, int);
template __global__ void tk<10>(Params, int);
template __global__ void tk<11>(Params, int);
template __global__ void tk<12>(Params, int);
#endif

#if MULTI_LAUNCH
__global__ void __launch_bounds__(512) phase_kernel(Params p, int ph) {
  __shared__ __attribute__((aligned(16))) unsigned char smem[SMEM_BYTES];
  run_phase(p, ph, smem);
}
#else
__global__ void __launch_bounds__(512) mega_kernel(Params p) {
  __shared__ __attribute__((aligned(16))) unsigned char smem[SMEM_BYTES];
  cg::grid_group grid = cg::this_grid();
  __shared__ uint4 xb_words;
  unsigned* bar = (unsigned*)(p.ws + WS_END + 256);
  if (threadIdx.x == 0) xb_words = make_uint4(0u, 0u, 0u, 0u);
  if (blockIdx.x == 0)
    for (int i = threadIdx.x; i < XCD_BAR_WORDS; i += 512) bar[i] = 0u;
  prologue_phase(p, smem);
  grid.sync();
  const XcdBarrier xb = xcd_barrier_post(bar, (volatile LAS unsigned*)&xb_words);
  norm_phase<0>(p, 0, smem);
  xcd_barrier(xb);
  {
    int L = 0;
    asm volatile("" : "+s"(L));
    layer_phase<0>(p, L, smem); xcd_barrier(xb);
    layer_phase<1>(p, L, smem); xcd_barrier(xb);
    layer_phase<2>(p, L, smem); xcd_barrier(xb);
    layer_phase<3>(p, L, smem); xcd_barrier(xb);
    layer_phase<4>(p, L, smem); xcd_barrier(xb);
    layer_phase<5>(p, L, smem); xcd_barrier(xb);
    layer_phase<6>(p, L, smem); xcd_barrier(xb);
    layer_phase<7>(p, L, smem); xcd_barrier(xb);
    layer_phase<8>(p, L, smem); xcd_barrier(xb);
    layer_phase<9>(p, L, smem); xcd_barrier(xb);
    layer_phase<10>(p, L, smem); xcd_barrier(xb);
  }
  {
    int L = 1;
    asm volatile("" : "+s"(L));
    layer_phase<0>(p, L, smem); xcd_barrier(xb);
    layer_phase<1>(p, L, smem); xcd_barrier(xb);
    layer_phase<2>(p, L, smem); xcd_barrier(xb);
    layer_phase<3>(p, L, smem); xcd_barrier(xb);
    layer_phase<4>(p, L, smem); xcd_barrier(xb);
    layer_phase<5>(p, L, smem); xcd_barrier(xb);
    layer_phase<6>(p, L, smem); xcd_barrier(xb);
    layer_phase<7>(p, L, smem); xcd_barrier(xb);
    layer_phase<8>(p, L, smem); xcd_barrier(xb);
    layer_phase<9>(p, L, smem); xcd_barrier(xb);
    layer_phase<10>(p, L, smem);
  }
}
#endif

extern "C" void kernel_launch(void* const* d_in, const int* in_sizes, int n_in, void* d_out, int out_size, void* d_ws,
                              size_t ws_size, hipStream_t stream) {
  if (n_in != 19 || ws_size < WS_END + 256 + XCD_BAR_WORDS * 4) {
    fprintf(stderr, "kernel_launch: unexpected n_in %d or ws_size %zu (< %zu)\n", n_in, ws_size, (size_t)WS_END);
    return;
  }
  Params p{};
  const float** pp = (const float**)&p;
  for (int i = 0; i < 19; ++i) pp[i] = (const float*)d_in[i];
  p.out = (float*)d_out;
  p.ws = (unsigned char*)d_ws;
#if MULTI_LAUNCH
  for (int ph = 0; ph < NPHASE; ++ph) hipLaunchKernelGGL(phase_kernel, dim3(256), dim3(512), 0, stream, p, ph);
#else
  static int grid_blocks = 0;
  if (!grid_blocks) {
    int dev = 0, cus = 0, per_cu = 0;
    hipGetDevice(&dev);
    hipDeviceGetAttribute(&cus, hipDeviceAttributeMultiprocessorCount, dev);
    hipOccupancyMaxActiveBlocksPerMultiprocessor(&per_cu, (const void*)mega_kernel, 512, 0);
    if (per_cu < 1) { fprintf(stderr, "kernel_launch: occupancy query says %d blocks/CU\n", per_cu); per_cu = 1; }
    grid_blocks = cus;
  }
  void* args[] = {&p};
  hipError_t e = hipLaunchCooperativeKernel((const void*)mega_kernel, dim3(grid_blocks), dim3(512), args, 0, stream);
  if (e != hipSuccess) fprintf(stderr, "cooperative launch failed: %s (grid %d)\n", hipGetErrorString(e), grid_blocks);
#endif
}
```

```cpp
#include <hip/hip_runtime.h>
#include <hip/hip_cooperative_groups.h>
#include <cstdio>
namespace cg = cooperative_groups;

typedef unsigned short u16;
typedef short bf16x8 __attribute__((ext_vector_type(8)));
typedef float f32x16 __attribute__((ext_vector_type(16)));
typedef __bf16 bf2_t __attribute__((ext_vector_type(2)));
typedef float f2_t __attribute__((ext_vector_type(2)));

#define DI __device__ __forceinline__
#define MFMA32(a, b, c) __builtin_amdgcn_mfma_f32_32x32x16_bf16((a), (b), (c), 0, 0, 0)

#ifndef MULTI_LAUNCH
#define MULTI_LAUNCH 0
#endif

constexpr int TLAT = 32768, TT = 33280, SEQ = 16384, NKEY = 16640;
constexpr int INC = 3088, DFF = 2816;
constexpr float EPS = 1e-6f;
constexpr size_t UB = (size_t)TT * 1024 * 2;
constexpr size_t OFF_WIN = 0;
constexpr size_t OFF_WOUT = OFF_WIN + 2ull * 3072 * 1024 * 2;
constexpr size_t OFF_WFI = OFF_WOUT + 2ull * 1024 * 1024 * 2;
constexpr size_t OFF_WFO = OFF_WFI + 2ull * 5632 * 1024 * 2;
constexpr size_t OFF_MOD = OFF_WFO + 2ull * 1024 * 2816 * 2;
constexpr size_t OFF_LAM = OFF_MOD + 2ull * 3 * 6144 * 4;
constexpr size_t OFF_DAC = OFF_LAM + 256;
constexpr size_t OFF_ROPE = OFF_DAC + 16640;
constexpr size_t OFF_XC = OFF_ROPE + 16384ull * 32 * 8;
constexpr size_t OFF_DTB = OFF_XC + 512ull * 1024 * 4;
constexpr size_t OFF_R0 = OFF_DTB + (size_t)TT * 16 * 4;
constexpr size_t OFF_R1 = OFF_R0 + UB;
constexpr size_t OFF_R3 = OFF_R1 + UB;
constexpr size_t OFF_R2 = OFF_R3 + UB;
constexpr size_t OFF_R4 = OFF_R2 + UB;
constexpr size_t OFF_R5 = OFF_R4 + UB;
constexpr size_t OFF_HB = OFF_R5 + 768ull * TT * 2;
constexpr size_t WS_END = OFF_HB + 2ull * 2 * 130 * 8 * 8192 * 2;
constexpr int SMEM_BYTES = 147456;

struct Params {
  const float *x, *c, *ctx, *c_ctx, *w_ada, *b_ada, *norm_g, *w_in, *conv_w, *conv_b, *a_log, *dt_bias, *d_skip,
      *ssd_norm_g, *diff_lambda, *subln_g, *w_out, *w_ffn_in, *w_ffn_out;
  float* out;
  unsigned char* ws;
};

DI unsigned pack2(float a, float b) {
  f2_t v = {a, b};
  bf2_t r = __builtin_convertvector(v, bf2_t);
  return __builtin_bit_cast(unsigned, r);
}
DI float blo(unsigned u) { return __uint_as_float(u << 16); }
DI float bhi(unsigned u) { return __uint_as_float(u & 0xffff0000u); }
DI float bf2f(u16 u) { return __uint_as_float(((unsigned)u) << 16); }
DI int crow(int i, int h) { return (i & 3) + 8 * (i >> 2) + 4 * h; }
DI float silu_f(float x) { return x * __builtin_amdgcn_rcpf(1.f + __expf(-x)); }
DI float wave_sum(float v) {
#pragma unroll
  for (int o = 32; o; o >>= 1) v += __shfl_xor(v, o);
  return v;
}
DI bf16x8 mk8(unsigned a, unsigned b, unsigned c, unsigned d) {
  uint4 u = {a, b, c, d};
  return __builtin_bit_cast(bf16x8, u);
}
DI int tid_() { int t = threadIdx.x; asm volatile("" : "+v"(t)); return t; }
DI int bid_() { int b = blockIdx.x; asm volatile("" : "+s"(b)); return b; }
DI int vblock() {
  int nb = gridDim.x, bid = bid_();
  return (nb % 8 == 0) ? (bid % 8) * (nb / 8) + bid / 8 : bid;
}

DI void transpose_tile(const float* __restrict__ W, int ldw, int k0, int n0, int ffn_q, u16* __restrict__ Wt, int K,
                       int dstrow0, unsigned char* st, int lane) {
  const int nn = (lane & 15) * 4;
  const int src = (ffn_q >= 0) ? (nn < 32 ? 32 * ffn_q + nn : DFF + 32 * ffn_q + nn - 32) : n0 + nn;
  float4 v[16];
#pragma unroll
  for (int j = 0; j < 16; ++j) v[j] = *(const float4*)(W + (size_t)(k0 + (lane >> 4) + 4 * j) * ldw + src);
#pragma unroll
  for (int j = 0; j < 16; ++j) {
    const int kk = (lane >> 4) + 4 * j;
    unsigned a = pack2(v[j].x, v[j].y), b = pack2(v[j].z, v[j].w);
    *(u16*)(st + (nn + 0) * 144 + kk * 2) = (u16)(a & 0xffffu);
    *(u16*)(st + (nn + 1) * 144 + kk * 2) = (u16)(a >> 16);
    *(u16*)(st + (nn + 2) * 144 + kk * 2) = (u16)(b & 0xffffu);
    *(u16*)(st + (nn + 3) * 144 + kk * 2) = (u16)(b >> 16);
  }
  __builtin_amdgcn_wave_barrier();
#pragma unroll
  for (int j = 0; j < 8; ++j) {
    const int row = (lane >> 3) + 8 * j, k8 = (lane & 7) * 8;
    uint4 o = *(const uint4*)(st + row * 144 + k8 * 2);
    *(uint4*)(Wt + (size_t)(dstrow0 + row) * K + k0 + k8) = o;
  }
  __builtin_amdgcn_wave_barrier();
}

DI void prologue_phase(const Params& p, unsigned char* smem) {
  const int tid = tid_(), lane = tid & 63, w = tid >> 6;
  float* st = (float*)smem;
  float* sv = (float*)(smem + 16640);
  float* red = (float*)(smem + 16640 + 12288);
  float* modb = (float*)(p.ws + OFF_MOD);
  for (int i = tid; i < 3072; i += 512) {
    int v = i >> 10, k = i & 1023;
    float cv = (v < 2) ? p.c[v * 1024 + k] : p.c_ctx[k];
    sv[i] = cv / (1.f + expf(-cv));
  }
  __syncthreads();
  const int nb = gridDim.x;
  const int NGEMV = 192, NTR = 3136 * 2;
  for (int it = bid_(); it < NGEMV; it += nb) {
    {
      int L = it / 96, chunk = it % 96;
      int col = chunk * 64 + lane;
      const float* wp = p.w_ada + (size_t)L * 1024 * 6144 + col;
      float a0 = 0.f, a1 = 0.f, a2 = 0.f;
#pragma unroll 16
      for (int kk = 0; kk < 128; ++kk) {
        int k = w * 128 + kk;
        float wv = wp[(size_t)k * 6144];
        a0 += sv[k] * wv;
        a1 += sv[1024 + k] * wv;
        a2 += sv[2048 + k] * wv;
      }
      red[(w * 3 + 0) * 64 + lane] = a0;
      red[(w * 3 + 1) * 64 + lane] = a1;
      red[(w * 3 + 2) * 64 + lane] = a2;
      __syncthreads();
      if (tid < 192) {
        int v = tid >> 6, ln = tid & 63;
        float s = 0.f;
#pragma unroll
        for (int ww = 0; ww < 8; ++ww) s += red[(ww * 3 + v) * 64 + ln];
        s += p.b_ada[L * 6144 + chunk * 64 + ln];
        modb[(L * 3 + v) * 6144 + chunk * 64 + ln] = s;
      }
      __syncthreads();
    }
  }
  {
    unsigned char* stw = smem + 40960 + w * 9216;
    for (int t = vblock() * 8 + w; t < NTR; t += nb * 8) {
      int L = t / 3136, idx = t % 3136;
      if (idx < 768) {
        int kt = idx / 48, nt = idx % 48;
        transpose_tile(p.w_in + (size_t)L * 1024 * INC, INC, kt * 64, nt * 64, -1,
                       (u16*)(p.ws + OFF_WIN) + (size_t)L * 3072 * 1024, 1024, nt * 64, stw, lane);
      } else if (idx < 1024) {
        int i2 = idx - 768, kt = i2 / 16, nt = i2 % 16;
        transpose_tile(p.w_out + (size_t)L * 1024 * 1024, 1024, kt * 64, nt * 64, -1,
                       (u16*)(p.ws + OFF_WOUT) + (size_t)L * 1024 * 1024, 1024, nt * 64, stw, lane);
      } else if (idx < 2432) {
        int i3 = idx - 1024, kt = i3 / 88, q = i3 % 88;
        transpose_tile(p.w_ffn_in + (size_t)L * 1024 * 5632, 5632, kt * 64, 0, q,
                       (u16*)(p.ws + OFF_WFI) + (size_t)L * 5632 * 1024, 1024, q * 64, stw, lane);
      } else {
        int i4 = idx - 2432, kt = i4 / 16, nt = i4 % 16;
        transpose_tile(p.w_ffn_out + (size_t)L * DFF * 1024, 1024, kt * 64, nt * 64, -1,
                       (u16*)(p.ws + OFF_WFO) + (size_t)L * 1024 * DFF, DFF, nt * 64, stw, lane);
      }
    }
  }
  float2* rope = (float2*)(p.ws + OFF_ROPE);
  for (int i = bid_() * 512 + tid; i < SEQ * 32; i += nb * 512) {
    int t = i >> 5, c = i & 31;
    float inv = powf(10000.f, -(float)(c & 15) / 16.f);
    float pos = (c < 16) ? (float)(t >> 6) : (float)(t & 63);
    float ang = pos * inv;
    rope[i] = make_float2(cosf(ang), sinf(ang));
  }
  if (bid_() == 0 && tid == 0) *(volatile unsigned*)(p.ws + OFF_LAM + 128) = 0u;
  if (bid_() == 0 && w < 2) {
    int L = w;
    const float* lv = p.diff_lambda + L * 256;
    float s01 = wave_sum(lv[lane] * lv[64 + lane]);
    float s23 = wave_sum(lv[128 + lane] * lv[192 + lane]);
    float lam_init = 0.8f - 0.6f * expf(-0.3f * (float)L);
    if (lane == 0) ((float*)(p.ws + OFF_LAM))[L] = expf(s01) - expf(s23) + lam_init;
  }
}

template <int MODE>
DI void norm_phase(const Params& p, int L, unsigned char* smem) {
  const int tid = tid_(), lane = tid & 63, w = tid >> 6;
  const int Lh = (MODE == 2) ? L + 1 : L;
  const bool do_h = (MODE != 2) || (L + 1 < 2);
  const bool do_dt = (MODE == 0) || (MODE == 2 && do_h);
  float* sW = (float*)smem;
  if (do_dt) {
    const float* wdt = p.w_in + (size_t)Lh * 1024 * INC + 3072;
#pragma unroll 8
    for (int i = tid; i < 16384; i += 512) {
      int k = i >> 4, c = i & 15;
      int kq = k >> 8, kk = k & 255;
      sW[(((kk >> 2) * 64 + kq * 16 + c) * 4) + (kk & 3)] = wdt[(size_t)k * INC + c];
    }
    __syncthreads();
  }
  const float* modL = (const float*)(p.ws + OFF_MOD) + L * 3 * 6144;
  const float* modH = (const float*)(p.ws + OFF_MOD) + (do_h ? Lh : 0) * 3 * 6144;
  float* xc = (float*)(p.ws + OFF_XC);
  const u16* br = (const u16*)(p.ws + OFF_R1);
  u16* hbuf = (u16*)(p.ws + OFF_R0);
  float* dtb = (float*)(p.ws + OFF_DTB);
  const int nb = gridDim.x;
  auto load_row = [&](int row, float (&xv)[16], float (&bv)[16]) {
    const float* xold;
    if (row < TLAT) xold = ((MODE == 0 || (MODE == 1 && L == 0)) ? p.x : p.out) + (size_t)row * 1024;
    else xold = ((MODE == 0 || (MODE == 1 && L == 0)) ? p.ctx : xc) + (size_t)(row - TLAT) * 1024;
#pragma unroll
    for (int j = 0; j < 2; ++j) {
      int c0 = j * 512 + lane * 8;
      float4 a = *(const float4*)(xold + c0), b = *(const float4*)(xold + c0 + 4);
      xv[j * 8 + 0] = a.x; xv[j * 8 + 1] = a.y; xv[j * 8 + 2] = a.z; xv[j * 8 + 3] = a.w;
      xv[j * 8 + 4] = b.x; xv[j * 8 + 5] = b.y; xv[j * 8 + 6] = b.z; xv[j * 8 + 7] = b.w;
    }
    if (MODE != 0) {
#pragma unroll
      for (int j = 0; j < 2; ++j) {
        uint4 u = *(const uint4*)(br + (size_t)row * 1024 + j * 512 + lane * 8);
        bv[j * 8 + 0] = blo(u.x); bv[j * 8 + 1] = bhi(u.x); bv[j * 8 + 2] = blo(u.y); bv[j * 8 + 3] = bhi(u.y);
        bv[j * 8 + 4] = blo(u.z); bv[j * 8 + 5] = bhi(u.z); bv[j * 8 + 6] = blo(u.w); bv[j * 8 + 7] = bhi(u.w);
      }
    }
  };
  auto process_row = [&](int row, float (&xv)[16], float (&bv)[16]) {
    const int v = (row < TLAT) ? (row >> 14) : 2;
    float* xnew = (row < TLAT) ? p.out + (size_t)row * 1024 : xc + (size_t)(row - TLAT) * 1024;
    if (MODE != 0) {
      float ssq = 0.f;
#pragma unroll
      for (int e = 0; e < 16; ++e) ssq += bv[e] * bv[e];
      ssq = wave_sum(ssq);
      const float rstd = rsqrtf(ssq * (1.f / 1024.f) + EPS);
      const float* g = p.norm_g + (L * 4 + (MODE == 1 ? 1 : 3)) * 1024;
      const float* gate = modL + v * 6144 + (MODE == 1 ? 2 : 5) * 1024;
#pragma unroll
      for (int j = 0; j < 2; ++j) {
        int c0 = j * 512 + lane * 8;
#pragma unroll
        for (int e = 0; e < 8; ++e) xv[j * 8 + e] += gate[c0 + e] * (bv[j * 8 + e] * rstd * g[c0 + e]);
        *(float4*)(xnew + c0) = make_float4(xv[j * 8 + 0], xv[j * 8 + 1], xv[j * 8 + 2], xv[j * 8 + 3]);
        *(float4*)(xnew + c0 + 4) = make_float4(xv[j * 8 + 4], xv[j * 8 + 5], xv[j * 8 + 6], xv[j * 8 + 7]);
      }
    }
    if (do_h) {
      float ssq = 0.f;
#pragma unroll
      for (int e = 0; e < 16; ++e) ssq += xv[e] * xv[e];
      ssq = wave_sum(ssq);
      const float rstd = rsqrtf(ssq * (1.f / 1024.f) + EPS);
      const float* g = p.norm_g + (Lh * 4 + (MODE == 1 ? 2 : 0)) * 1024;
      const float* sh = modH + v * 6144 + (MODE == 1 ? 3 : 0) * 1024;
      const float* sc = modH + v * 6144 + (MODE == 1 ? 4 : 1) * 1024;
#pragma unroll
      for (int j = 0; j < 2; ++j) {
        int c0 = j * 512 + lane * 8;
#pragma unroll
        for (int e = 0; e < 8; ++e) xv[j * 8 + e] = xv[j * 8 + e] * rstd * g[c0 + e] * (1.f + sc[c0 + e]) + sh[c0 + e];
        uint4 o = {pack2(xv[j * 8 + 0], xv[j * 8 + 1]), pack2(xv[j * 8 + 2], xv[j * 8 + 3]),
                   pack2(xv[j * 8 + 4], xv[j * 8 + 5]), pack2(xv[j * 8 + 6], xv[j * 8 + 7])};
        *(uint4*)(hbuf + (size_t)row * 1024 + c0) = o;
      }
      if (do_dt) {
        float* hw = (float*)(smem + 65536) + w * 1040;
#pragma unroll
        for (int j = 0; j < 2; ++j) {
          int c0 = j * 512 + lane * 8, kq = c0 >> 8, kk = c0 & 255;
          *(float4*)(hw + kq * 260 + kk) = make_float4(xv[j * 8 + 0], xv[j * 8 + 1], xv[j * 8 + 2], xv[j * 8 + 3]);
          *(float4*)(hw + kq * 260 + kk + 4) = make_float4(xv[j * 8 + 4], xv[j * 8 + 5], xv[j * 8 + 6], xv[j * 8 + 7]);
        }
        __builtin_amdgcn_wave_barrier();
        const float* wq = sW + ((lane >> 4) * 16 + (lane & 15)) * 4;
        const float* hq = hw + (lane >> 4) * 260;
        float acc = 0.f;
#pragma unroll 8
        for (int k4 = 0; k4 < 64; ++k4) {
          float4 wv = *(const float4*)(wq + k4 * 256);
          float4 hv = *(const float4*)(hq + k4 * 4);
          acc += wv.x * hv.x + wv.y * hv.y + wv.z * hv.z + wv.w * hv.w;
        }
        acc += __shfl_xor(acc, 16);
        acc += __shfl_xor(acc, 32);
        __builtin_amdgcn_wave_barrier();
        if (lane < 16) {
          float xx = acc + p.dt_bias[Lh * 16 + lane];
          dtb[(size_t)row * 16 + lane] = fmaxf(xx, 0.f) + log1pf(expf(-fabsf(xx)));
        }
      }
    }
  };
  for (int pr = bid_() * 8 + w; pr < TLAT / 2; pr += nb * 8) {
    float xa[16], xb[16], ba[16], bb[16];
    load_row(2 * pr, xa, ba);
    load_row(2 * pr + 1, xb, bb);
    process_row(2 * pr, xa, ba);
    process_row(2 * pr + 1, xb, bb);
  }
  if (!(MODE != 0 && L == 1)) {
    for (int row = TLAT + bid_() * 8 + w; row < TT; row += nb * 8) {
      float xa[16], ba[16];
      load_row(row, xa, ba);
      process_row(row, xa, ba);
    }
  }
}

enum { EPI_PLAIN = 0, EPI_INPROJ = 1, EPI_FFNIN = 2 };
struct EpiArgs {
  u16* dst;
  int ldd;
  u16 *qk, *vT, *zb, *xraw;
  const float2* rope;
};

template <int EPI, int MT = 4>
DI void gemm_phase(const u16* A, int lda, const u16* Bt, int ldb, int K, int ntn, int nmt, int mrow0,
                   const EpiArgs& ea, unsigned char* smem) {
  const int tid = tid_(), lane = tid & 63, w = tid >> 6, wm = w >> 2, wn = w & 3;
  const int r = lane & 31, h = lane >> 5;
  const int nk = K / 64;
  const int ntiles = nmt * ntn;
  const int nb = gridDim.x;
  for (int tile = vblock(); tile < ntiles; tile += nb) {
    const int nig = 8 * ntn, gid = tile / nig, fm = gid * 8, gsz = min(nmt - fm, 8);
    const int mtile = fm + (tile % nig) % gsz, ntile = (tile % nig) / gsz;
    const int m0 = mrow0 + mtile * (64 * MT), n0 = ntile * 256;
    f32x16 acc[MT][2];
#pragma unroll
    for (int a = 0; a < MT; ++a)
#pragma unroll
      for (int b = 0; b < 2; ++b)
#pragma unroll
        for (int i = 0; i < 16; ++i) acc[a][b][i] = 0.f;
    const int sws = (tid & 7) ^ ((tid >> 4) & 7);
    const u16* Ap = A + (size_t)(m0 + (tid >> 3)) * lda + sws * 8;
    const u16* Bp = Bt + (size_t)(n0 + (tid >> 3)) * ldb + sws * 8;
#define GLDS(kt, stg)                                                                                         \
  {                                                                                                           \
    unsigned char* ld_ = smem + (stg) * 65536 + tid * 16;                                                     \
    _Pragma("unroll") for (int j = 0; j < MT; ++j)                                                            \
      __builtin_amdgcn_global_load_lds((const unsigned*)(Ap + (size_t)(64 * j) * lda + (kt) * 64),            \
                                       (unsigned*)(ld_ + j * 8192), 16, 0, 0);                                \
    _Pragma("unroll") for (int j = 0; j < 4; ++j)                                                             \
      __builtin_amdgcn_global_load_lds((const unsigned*)(Bp + (size_t)(64 * j) * ldb + (kt) * 64),            \
                                       (unsigned*)(ld_ + 32768 + j * 8192), 16, 0, 0);                        \
  }
    const int xr = (r >> 1) & 7;
    const int fo0 = ((0 + h) ^ xr) * 16, fo1 = ((2 + h) ^ xr) * 16, fo2 = ((4 + h) ^ xr) * 16, fo3 = ((6 + h) ^ xr) * 16;
    GLDS(0, 0);
    asm volatile("s_waitcnt vmcnt(0)" ::: "memory");
    __syncthreads();
    for (int kt = 0; kt < nk; ++kt) {
      if (kt + 1 < nk) GLDS(kt + 1, (kt + 1) & 1);
      asm volatile("" ::: "memory");
      __builtin_amdgcn_sched_barrier(0);
      const unsigned char* sa = smem + (kt & 1) * 65536 + (wm * (32 * MT) + r) * 128;
      const unsigned char* sb = smem + (kt & 1) * 65536 + 32768 + (wn * 64 + r) * 128;
#pragma unroll
      for (int ks = 0; ks < 4; ++ks) {
        const int fo = (ks == 0) ? fo0 : (ks == 1) ? fo1 : (ks == 2) ? fo2 : fo3;
        bf16x8 af[MT], bfr[2];
#pragma unroll
        for (int a = 0; a < MT; ++a) af[a] = *(const bf16x8*)(sa + a * 32 * 128 + fo);
#pragma unroll
        for (int b = 0; b < 2; ++b) bfr[b] = *(const bf16x8*)(sb + b * 32 * 128 + fo);
#pragma unroll
        for (int a = 0; a < MT; ++a)
#pragma unroll
          for (int b = 0; b < 2; ++b) acc[a][b] = MFMA32(af[a], bfr[b], acc[a][b]);
      }
      if (MT == 4) {
        __builtin_amdgcn_sched_group_barrier(0x100, 8, 0);
#pragma unroll
        for (int g_ = 0; g_ < 16; ++g_) {
          __builtin_amdgcn_sched_group_barrier(0x8, 1, 0);
          __builtin_amdgcn_sched_group_barrier(0x100, 1, 0);
        }
        __builtin_amdgcn_sched_group_barrier(0x8, 16, 0);
      }
      __builtin_amdgcn_sched_barrier(0);
      asm volatile("s_waitcnt vmcnt(0)" ::: "memory");
      __syncthreads();
    }
#undef GLDS
    int te = tid;
    asm volatile("" : "+v"(te));
    {
    const int tid = te, lane = tid & 63, w = tid >> 6, wm = w >> 2, wn = w & 3;
    const int r = lane & 31, h = lane >> 5;
    (void)lane; (void)w;
    if (EPI == EPI_FFNIN) {
#pragma unroll
      for (int a = 0; a < MT; ++a)
#pragma unroll
        for (int i = 0; i < 16; ++i) {
          float gte = acc[a][0][i], up = acc[a][1][i];
          float vv = silu_f(gte) * up;
          int row = wm * (32 * MT) + a * 32 + crow(i, h);
          *(u16*)(smem + row * 272 + (wn * 32 + r) * 2) = (u16)(pack2(vv, 0.f) & 0xffffu);
        }
      __syncthreads();
#pragma unroll
      for (int j = 0; j < 2 * MT; ++j) {
        int c = tid + 512 * j, row = c >> 4, ch = c & 15;
        uint4 v = *(const uint4*)(smem + row * 272 + ch * 16);
        *(uint4*)(ea.dst + (size_t)(m0 + row) * ea.ldd + ntile * 128 + ch * 8) = v;
      }
      __syncthreads();
    } else {
      bool transposed = false;
      if (EPI == EPI_INPROJ) {
        transposed = (ntile == 4 || ntile == 5);
        if (ntile < 4 && MT == 4 && mtile < 128) {
#pragma unroll
          for (int a = 0; a < MT; ++a)
#pragma unroll
            for (int i = 0; i < 16; ++i) {
              int row = wm * (32 * MT) + a * 32 + crow(i, h);
              int t = (m0 + row) & (SEQ - 1);
              float2 cs = ea.rope[t * 32 + r];
              float u1 = acc[a][0][i], u2 = acc[a][1][i];
              acc[a][0][i] = u1 * cs.x - u2 * cs.y;
              acc[a][1][i] = u1 * cs.y + u2 * cs.x;
            }
        }
      }
      if (!transposed) {
#pragma unroll
        for (int a = 0; a < MT; ++a)
#pragma unroll
          for (int b = 0; b < 2; ++b)
#pragma unroll
            for (int i = 0; i < 16; ++i) {
              int row = wm * (32 * MT) + a * 32 + crow(i, h);
              int col = wn * 64 + b * 32 + r;
              *(u16*)(smem + row * 528 + col * 2) = (u16)(pack2(acc[a][b][i], 0.f) & 0xffffu);
            }
      } else {
#pragma unroll
        for (int a = 0; a < MT; ++a)
#pragma unroll
          for (int b = 0; b < 2; ++b)
#pragma unroll
            for (int g = 0; g < 4; ++g) {
              int col = wn * 64 + b * 32 + r;
              int row = wm * (32 * MT) + a * 32 + 8 * g + 4 * h;
              uint2 v = {pack2(acc[a][b][4 * g + 0], acc[a][b][4 * g + 1]), pack2(acc[a][b][4 * g + 2], acc[a][b][4 * g + 3])};
              *(uint2*)(smem + col * 528 + row * 2) = v;
            }
      }
      __syncthreads();
      u16* dbase;
      size_t dld;
      if (EPI == EPI_PLAIN) {
        dbase = ea.dst + (size_t)m0 * ea.ldd + n0;
        dld = ea.ldd;
      } else {
        if (ntile < 4) {
          dbase = ea.qk + (size_t)m0 * 1024 + n0;
          dld = 1024;
        } else if (ntile < 6) {
          int b = (MT == 1) ? (mtile >> 2) : ((mtile < 128) ? (mtile >> 6) : (mtile - 128));
          int keybase = (MT == 1) ? (mtile & 3) * 64 : ((mtile < 128) ? 256 + (mtile & 63) * 256 : 0);
          dbase = ea.vT + ((size_t)(b * 4) * 128 + (size_t)(ntile - 4) * 256) * NKEY + keybase;
          dld = NKEY;
        } else if (ntile < 8) {
          dbase = ea.zb + (size_t)m0 * 512 + (ntile - 6) * 256;
          dld = 512;
        } else {
          dbase = ea.xraw + (size_t)m0 * 1024 + (ntile - 8) * 256;
          dld = 1024;
        }
      }
      if (MT == 1 && transposed) {
#pragma unroll
        for (int j = 0; j < 4; ++j) {
          const int c = tid + 512 * j, row = c >> 3, ch = c & 7;
          uint4 v = *(const uint4*)(smem + row * 528 + ch * 16);
          *(uint4*)(dbase + (size_t)row * dld + ch * 8) = v;
        }
      } else {
        const unsigned char* sp = smem + (tid >> 5) * 528 + (tid & 31) * 16;
        u16* dp = dbase + (size_t)(tid >> 5) * dld + (tid & 31) * 8;
#pragma unroll 4
        for (int j = 0; j < 4 * MT; ++j) {
          uint4 v = *(const uint4*)sp;
          *(uint4*)dp = v;
          sp += 16 * 528;
          dp += 16 * dld;
        }
      }
      __syncthreads();
    }
    }
  }
}

DI void conv_item(const Params& p, int L, int item, unsigned char* smem) {
  const int tid = tid_();
  const u16* xraw = (const u16*)(p.ws + OFF_R3);
  u16* xbcc = (u16*)(p.ws + OFF_R0);
  u16* xbcT = (u16*)(p.ws + OFF_R5);
  const int cgk = item >> 2, slab = item & 3;
  const int row0 = cgk * 128;
  int lo, hi;
  if (cgk < 256) { lo = (cgk >> 7) * SEQ; hi = lo + SEQ; }
  else { lo = TLAT + ((cgk - 256) >> 1) * 256; hi = lo + 256; }
  unsigned char* sRaw = smem;
  unsigned char* sT = smem + 69696;
  for (int c = tid; c < 132 * 32; c += 512) {
    int rr = c >> 5, ch = c & 31;
    int grow = row0 - 2 + rr;
    uint4 v = {0u, 0u, 0u, 0u};
    if (grow >= lo && grow < hi) v = *(const uint4*)(xraw + (size_t)grow * 1024 + slab * 256 + ch * 8);
    *(uint4*)(sRaw + rr * 528 + ch * 16) = v;
  }
  __syncthreads();
  const int ch8 = tid & 31, cbase = slab * 256 + ch8 * 8;
  float wgt[5][8], bias8[8];
  {
    float4 b0 = *(const float4*)(p.conv_b + L * 1024 + cbase), b1 = *(const float4*)(p.conv_b + L * 1024 + cbase + 4);
    bias8[0] = b0.x; bias8[1] = b0.y; bias8[2] = b0.z; bias8[3] = b0.w; bias8[4] = b1.x; bias8[5] = b1.y; bias8[6] = b1.z; bias8[7] = b1.w;
#pragma unroll
    for (int jj = 0; jj < 5; ++jj) {
      const float* wp = p.conv_w + (size_t)(L * 5 + jj) * 1024 + cbase;
      float4 w0 = *(const float4*)wp, w1 = *(const float4*)(wp + 4);
      wgt[jj][0] = w0.x; wgt[jj][1] = w0.y; wgt[jj][2] = w0.z; wgt[jj][3] = w0.w;
      wgt[jj][4] = w1.x; wgt[jj][5] = w1.y; wgt[jj][6] = w1.z; wgt[jj][7] = w1.w;
    }
  }
#pragma unroll 2
  for (int j = 0; j < 8; ++j) {
    int t = (tid >> 5) + 16 * j;
    float acc[8];
#pragma unroll
    for (int e = 0; e < 8; ++e) acc[e] = bias8[e];
#pragma unroll
    for (int jj = 0; jj < 5; ++jj) {
      uint4 v = *(const uint4*)(sRaw + (t + jj) * 528 + ch8 * 16);
      acc[0] += wgt[jj][0] * blo(v.x); acc[1] += wgt[jj][1] * bhi(v.x); acc[2] += wgt[jj][2] * blo(v.y); acc[3] += wgt[jj][3] * bhi(v.y);
      acc[4] += wgt[jj][4] * blo(v.z); acc[5] += wgt[jj][5] * bhi(v.z); acc[6] += wgt[jj][6] * blo(v.w); acc[7] += wgt[jj][7] * bhi(v.w);
    }
#pragma unroll
    for (int e = 0; e < 8; ++e) acc[e] = silu_f(acc[e]);
    uint4 o = {pack2(acc[0], acc[1]), pack2(acc[2], acc[3]), pack2(acc[4], acc[5]), pack2(acc[6], acc[7])};
    *(uint4*)(xbcc + (size_t)(row0 + t) * 1024 + cbase) = o;
    if (slab < 3) {
      unsigned char* d = sT + (ch8 * 8) * 272 + t * 2;
      *(u16*)(d + 0 * 272) = (u16)(o.x & 0xffffu); *(u16*)(d + 1 * 272) = (u16)(o.x >> 16);
      *(u16*)(d + 2 * 272) = (u16)(o.y & 0xffffu); *(u16*)(d + 3 * 272) = (u16)(o.y >> 16);
      *(u16*)(d + 4 * 272) = (u16)(o.z & 0xffffu); *(u16*)(d + 5 * 272) = (u16)(o.z >> 16);
      *(u16*)(d + 6 * 272) = (u16)(o.w & 0xffffu); *(u16*)(d + 7 * 272) = (u16)(o.w >> 16);
    }
  }
  __syncthreads();
  if (slab < 3) {
#pragma unroll
    for (int j = 0; j < 8; ++j) {
      int c = tid + 512 * j, ch = c >> 4, t8 = c & 15;
      uint4 v = *(const uint4*)(sT + ch * 272 + t8 * 16);
      *(uint4*)(xbcT + (size_t)(slab * 256 + ch) * TT + row0 + t8 * 8) = v;
    }
  }
  __syncthreads();
}

#pragma float_control(push)
#pragma float_control(precise, off)
DI void attn_unit(const Params& p, int L, int unit, unsigned char* smem) {
  const int tid = tid_(), lane = tid & 63, w = tid >> 6;
  const int r = lane & 31, h = lane >> 5;
  const int m = w & 1, qs = w >> 1;
  const u16* qk = (const u16*)(p.ws + OFF_R1);
  const u16* vT = (const u16*)(p.ws + OFF_R2);
  u16* mixin = (u16*)(p.ws + OFF_R4);
  const float lam = ((const float*)(p.ws + OFF_LAM))[L];
  const float lam_init = 0.8f - 0.6f * expf(-0.3f * (float)L);
  int b, hh, qrow0, nkt;
  if (unit < 1024) { b = unit >> 9; hh = (unit >> 7) & 3; qrow0 = b * SEQ + (unit & 127) * 128; nkt = NKEY / 64; }
  else { int u2 = unit - 1024; b = u2 >> 3; hh = (u2 >> 1) & 3; qrow0 = TLAT + b * 256 + (u2 & 1) * 128; nkt = 4; }
  const int ctxrow0 = TLAT + b * 256, latrow0 = b * SEQ - 256;
  bf16x8 Qf[4];
  {
    const float qsc = 0.125f * 1.4426950408889634f;
    const u16* qp = qk + (size_t)(qrow0 + qs * 32 + r) * 1024 + hh * 128 + m * 64 + h * 8;
#pragma unroll
    for (int ks = 0; ks < 4; ++ks) {
      uint4 u = *(const uint4*)(qp + ks * 16);
      Qf[ks] = mk8(pack2(blo(u.x) * qsc, bhi(u.x) * qsc), pack2(blo(u.y) * qsc, bhi(u.y) * qsc),
                   pack2(blo(u.z) * qsc, bhi(u.z) * qsc), pack2(blo(u.w) * qsc, bhi(u.w) * qsc));
    }
  }
  f32x16 O[4];
#pragma unroll
  for (int e = 0; e < 4; ++e)
#pragma unroll
    for (int i = 0; i < 16; ++i) O[e][i] = 0.f;
  const u16* kcol = qk + 512 + hh * 128 + (((tid & 15) ^ ((tid >> 4) & 15)) * 8);
  const u16* vbase = vT + ((size_t)(b * 4 + hh) * 128 + (tid >> 3)) * NKEY + (((tid & 7) ^ ((tid >> 4) & 7)) * 8);
#define KGLDS(kt, stg)                                                                                         \
  {                                                                                                            \
    int kk0 = (kt) * 64;                                                                                       \
    int krow = (kk0 < 256) ? (ctxrow0 + kk0) : (latrow0 + kk0);                                                \
    unsigned char* ld_ = smem + (stg) * 16384 + tid * 16;                                                      \
    __builtin_amdgcn_global_load_lds((const unsigned*)(kcol + (size_t)(krow + (tid >> 4)) * 1024), (unsigned*)(ld_), 16, 0, 0);            \
    __builtin_amdgcn_global_load_lds((const unsigned*)(kcol + (size_t)(krow + (tid >> 4) + 32) * 1024), (unsigned*)(ld_ + 8192), 16, 0, 0); \
  }
#define VGLDS(kt, stg)                                                                                         \
  {                                                                                                            \
    unsigned char* ld_ = smem + 65536 + (stg) * 16384 + tid * 16;                                              \
    __builtin_amdgcn_global_load_lds((const unsigned*)(vbase + (kt) * 64), (unsigned*)(ld_), 16, 0, 0);        \
    __builtin_amdgcn_global_load_lds((const unsigned*)(vbase + (size_t)64 * NKEY + (kt) * 64), (unsigned*)(ld_ + 8192), 16, 0, 0); \
  }
  const int kpr = (r & 0x13) | ((r & 4) << 1) | ((r & 8) >> 1);
  const float THR = 8.f;
  f32x16 zero16;
#pragma unroll
  for (int i = 0; i < 16; ++i) zero16[i] = 0.f;
  float mrun = 0.f, lrun = 0.f;
  const bf16x8 Kb = mk8(h == 0 ? 0x3F80u : 0u, 0u, 0u, 0u);
  bf16x8 Qb = mk8(0u, 0u, 0u, 0u);
  const unsigned char* kbase = smem + kpr * 256;
  const int kx = kpr & 15, vx = (r >> 1) & 7;
  const int ko0 = ((m * 8 + 0 + h) ^ kx) * 16, ko1 = ((m * 8 + 2 + h) ^ kx) * 16, ko2 = ((m * 8 + 4 + h) ^ kx) * 16,
            ko3 = ((m * 8 + 6 + h) ^ kx) * 16;
  const int vo0 = ((0 + h) ^ vx) * 16, vo1 = ((2 + h) ^ vx) * 16, vo2 = ((4 + h) ^ vx) * 16, vo3 = ((6 + h) ^ vx) * 16;
  const unsigned char* vbase_l = smem + 65536 + r * 128;
#define SCOMP(stg, SA, SB)                                                        \
  {                                                                               \
    const unsigned char* kb = kbase + (stg) * 16384;                              \
    SA = MFMA32(Kb, Qb, zero16);                                                  \
    SB = MFMA32(Kb, Qb, zero16);                                                  \
    SA = MFMA32(*(const bf16x8*)(kb + ko0), Qf[0], SA);                                 \
    SB = MFMA32(*(const bf16x8*)(kb + 8192 + ko0), Qf[0], SB);                      \
    SA = MFMA32(*(const bf16x8*)(kb + ko1), Qf[1], SA);                            \
    SB = MFMA32(*(const bf16x8*)(kb + 8192 + ko1), Qf[1], SB);                 \
    SA = MFMA32(*(const bf16x8*)(kb + ko2), Qf[2], SA);                            \
    SB = MFMA32(*(const bf16x8*)(kb + 8192 + ko2), Qf[2], SB);                 \
    SA = MFMA32(*(const bf16x8*)(kb + ko3), Qf[3], SA);                            \
    SB = MFMA32(*(const bf16x8*)(kb + 8192 + ko3), Qf[3], SB);                 \
  }
#define TILEMAX(SA, SB, out)                                                      \
  {                                                                               \
    float t_ = fmaxf(SA[0], SB[0]);                                               \
    _Pragma("unroll") for (int i = 1; i < 16; ++i) t_ = fmaxf(t_, fmaxf(SA[i], SB[i])); \
    out = fmaxf(t_, __shfl_xor(t_, 32));                                          \
  }
#define LDF(p_) (*(const bf16x8*)(p_))
#define GRP(nm, vpm)                                                                  \
  __builtin_amdgcn_sched_group_barrier(0x100, 4, 0);                                  \
  _Pragma("unroll") for (int g_ = 0; g_ < (nm); ++g_) {                               \
    __builtin_amdgcn_sched_group_barrier(0x8, 1, 0);                                  \
    __builtin_amdgcn_sched_group_barrier(0x402, (vpm), 0);                            \
  }                                                                                   \
  __builtin_amdgcn_sched_barrier(0);
#define FB(x_) __float_as_int(x_)
#define PMAX4(SA, SB, i0, acc_)                                                       \
  acc_ = max(acc_, max(max(FB(SA[i0]), FB(SB[i0])), max(FB(SA[i0 + 1]), FB(SB[i0 + 1]))));            \
  acc_ = max(acc_, max(max(FB(SA[i0 + 2]), FB(SB[i0 + 2])), max(FB(SA[i0 + 3]), FB(SB[i0 + 3]))));
#define ASTEP(KT, CA, CB, NA, NB)                                                                        \
  {                                                                                                      \
    const int kt_ = (KT);                                                                                \
    if (kt_ + 3 < nkt) KGLDS(kt_ + 3, (kt_ + 3) & 3);                                                    \
    if (kt_ + 2 < nkt) VGLDS(kt_ + 2, (kt_ + 2) & 3);                                                    \
    __builtin_amdgcn_sched_barrier(0);                                                                   \
    const unsigned char* kb = kbase + ((kt_ + 1) & 3) * 16384;                                           \
    const unsigned char* vb = vbase_l + (kt_ & 3) * 16384;                                               \
                             \
    bf16x8 v2a = LDF(vb + vo0), v2b = LDF(vb + vo1), v2c = LDF(vb + 4096 + vo0), v2d = LDF(vb + 4096 + vo1);       \
    NA = MFMA32(Kb, Qb, zero16);                                                                         \
    NB = MFMA32(Kb, Qb, zero16);                                                                         \
    NA = MFMA32(k0a, Qf[0], NA);                                                                         \
    NB = MFMA32(k0b, Qf[0], NB);                                                                         \
    NA = MFMA32(k0c, Qf[1], NA);                                                                         \
    NB = MFMA32(k0d, Qf[1], NB);                                                                         \
    float ps_ = 0.f;                                                                                     \
    _Pragma("unroll") for (int i = 0; i < 8; ++i) { CA[i] = __builtin_amdgcn_exp2f(CA[i]); ps_ += CA[i]; } \
    GRP(6, 3)                                                                                            \
                                    \
    bf16x8 v3a = LDF(vb + 8192 + vo0), v3b = LDF(vb + 8192 + vo1), v3c = LDF(vb + 12288 + vo0), v3d = LDF(vb + 12288 + vo1);   \
    NA = MFMA32(g1a, Qf[2], NA);                                                                         \
    NB = MFMA32(g1b, Qf[2], NB);                                                                         \
    NA = MFMA32(g1c, Qf[3], NA);                                                                         \
    NB = MFMA32(g1d, Qf[3], NB);                                                                         \
    _Pragma("unroll") for (int i = 8; i < 16; ++i) { CA[i] = __builtin_amdgcn_exp2f(CA[i]); ps_ += CA[i]; } \
    bf16x8 P00 = mk8(pack2(CA[0], CA[1]), pack2(CA[2], CA[3]), pack2(CA[4], CA[5]), pack2(CA[6], CA[7]));        \
    bf16x8 P01 = mk8(pack2(CA[8], CA[9]), pack2(CA[10], CA[11]), pack2(CA[12], CA[13]), pack2(CA[14], CA[15]));  \
    GRP(4, 6)                                                                                            \
                \
    bf16x8 v4a = LDF(vb + vo2), v4b = LDF(vb + vo3), v4c = LDF(vb + 4096 + vo2), v4d = LDF(vb + 4096 + vo3); \
    O[0] = MFMA32(v2a, P00, O[0]);                                                                       \
    O[0] = MFMA32(v2b, P01, O[0]);                                                                       \
    O[1] = MFMA32(v2c, P00, O[1]);                                                                       \
    O[1] = MFMA32(v2d, P01, O[1]);                                                                       \
    _Pragma("unroll") for (int i = 0; i < 8; ++i) { CB[i] = __builtin_amdgcn_exp2f(CB[i]); ps_ += CB[i]; } \
    int tni_ = max(FB(NA[0]), FB(NB[0]));                                                                \
    PMAX4(NA, NB, 0, tni_)                                                                                \
    GRP(4, 5)                                                                                            \
          \
    bf16x8 v5a = LDF(vb + 8192 + vo2), v5b = LDF(vb + 8192 + vo3), v5c = LDF(vb + 12288 + vo2), v5d = LDF(vb + 12288 + vo3); \
    O[2] = MFMA32(v3a, P00, O[2]);                                                                       \
    O[2] = MFMA32(v3b, P01, O[2]);                                                                       \
    O[3] = MFMA32(v3c, P00, O[3]);                                                                       \
    O[3] = MFMA32(v3d, P01, O[3]);                                                                       \
    _Pragma("unroll") for (int i = 8; i < 16; ++i) { CB[i] = __builtin_amdgcn_exp2f(CB[i]); ps_ += CB[i]; } \
    bf16x8 P10 = mk8(pack2(CB[0], CB[1]), pack2(CB[2], CB[3]), pack2(CB[4], CB[5]), pack2(CB[6], CB[7]));        \
    bf16x8 P11 = mk8(pack2(CB[8], CB[9]), pack2(CB[10], CB[11]), pack2(CB[12], CB[13]), pack2(CB[14], CB[15]));  \
    PMAX4(NA, NB, 4, tni_)                                                                               \
    GRP(4, 7)                                                                                            \
                              \
    O[0] = MFMA32(v4a, P10, O[0]);                                                                       \
    O[0] = MFMA32(v4b, P11, O[0]);                                                                       \
    O[1] = MFMA32(v4c, P10, O[1]);                                                                       \
    O[1] = MFMA32(v4d, P11, O[1]);                                                                       \
    PMAX4(NA, NB, 8, tni_)                                                                               \
    GRP(4, 1)                                                                                            \
                                                  \
    O[2] = MFMA32(v5a, P10, O[2]);                                                                       \
    O[2] = MFMA32(v5b, P11, O[2]);                                                                       \
    O[3] = MFMA32(v5c, P10, O[3]);                                                                       \
    O[3] = MFMA32(v5d, P11, O[3]);                                                                       \
    PMAX4(NA, NB, 12, tni_)                                                                              \
    tni_ = max(tni_, __shfl_xor(tni_, 32));                                                              \
    const float tn_ = __int_as_float(tni_);                                                               \
    __builtin_amdgcn_sched_barrier(0);                                                                   \
    lrun += ps_;                                                                                         \
    if (kt_ + 1 < nkt && __any(tn_ > THR)) {                                                             \
      const float mnew = blo(pack2(mrun + fmaxf(tn_, 0.f), 0.f));                                        \
      const float dlt = mnew - mrun;                                                                     \
      const float alpha = __builtin_amdgcn_exp2f(-dlt);                                                  \
      mrun = mnew;                                                                                       \
      Qb = mk8(h == 0 ? (pack2(-mrun, 0.f) & 0xffffu) : 0u, 0u, 0u, 0u);                                 \
      lrun *= alpha;                                                                                     \
      _Pragma("unroll") for (int i = 0; i < 16; ++i) { NA[i] -= dlt; NB[i] -= dlt; }                     \
      _Pragma("unroll") for (int e = 0; e < 4; ++e)                                                      \
        _Pragma("unroll") for (int i = 0; i < 16; ++i) O[e][i] *= alpha;                                 \
    }                                                                                                    \
    if ((kt_ & 1) == 0) { asm volatile("s_waitcnt vmcnt(0)" ::: "memory"); __syncthreads(); }           \
    {                                                                                                    \
      const unsigned char* kn = kbase + ((kt_ + 2) & 3) * 16384;                                         \
      k0a = LDF(kn + ko0);                                                                                     \
      k0b = LDF(kn + 8192 + ko0);                                                                          \
      k0c = LDF(kn + ko1);                                                                                \
      k0d = LDF(kn + 8192 + ko1);                                                                     \
      g1a = LDF(kn + ko2);                                                                               \
      g1b = LDF(kn + 8192 + ko2);                                                                        \
      g1c = LDF(kn + ko3);                                                                               \
      g1d = LDF(kn + 8192 + ko3);                                                                        \
    }                                                                                                    \
  }
  bf16x8 k0a, k0b, k0c, k0d, g1a, g1b, g1c, g1d;
  f32x16 Sa0, Sa1, Sb0, Sb1;
  KGLDS(0, 0);
  VGLDS(0, 0);
  KGLDS(1, 1);
  VGLDS(1, 1);
  KGLDS(2, 2);
  asm volatile("s_waitcnt vmcnt(0)" ::: "memory");
  __syncthreads();
  SCOMP(0, Sa0, Sa1);
  {
    float t0;
    TILEMAX(Sa0, Sa1, t0);
    mrun = blo(pack2(t0, 0.f));
    Qb = mk8(h == 0 ? (pack2(-mrun, 0.f) & 0xffffu) : 0u, 0u, 0u, 0u);
#pragma unroll
    for (int i = 0; i < 16; ++i) { Sa0[i] -= mrun; Sa1[i] -= mrun; }
  }
  {
    const unsigned char* kn = kbase + 16384;
    k0a = LDF(kn + ko0);
    k0b = LDF(kn + 8192 + ko0);
    k0c = LDF(kn + ko1);
    k0d = LDF(kn + 8192 + ko1);
    g1a = LDF(kn + ko2);
    g1b = LDF(kn + 8192 + ko2);
    g1c = LDF(kn + ko3);
    g1d = LDF(kn + 8192 + ko3);
  }
  for (int kt = 0; kt < nkt; kt += 2) {
    ASTEP(kt, Sa0, Sa1, Sb0, Sb1);
    ASTEP(kt + 1, Sb0, Sb1, Sa0, Sa1);
  }
  __syncthreads();
#undef ASTEP
#undef GRP
#undef PMAX4
#undef FB
#undef LDF
#undef TILEMAX
#undef SCOMP
#undef KGLDS
#undef VGLDS
  lrun += __shfl_xor(lrun, 32);
  const float inv = 1.f / lrun;
  float* sX = (float*)(smem + 71680);
  unsigned char* sO = smem;
  if (m == 1) {
    const float sc = lam * inv;
#pragma unroll
    for (int e = 0; e < 4; ++e)
#pragma unroll
      for (int i = 0; i < 16; ++i) sX[(qs * 64 + e * 16 + i) * 64 + lane] = O[e][i] * sc;
  }
  __syncthreads();
  if (m == 0) {
    float ssq = 0.f;
#pragma unroll
    for (int e = 0; e < 4; ++e)
#pragma unroll
      for (int i = 0; i < 16; ++i) {
        float o = O[e][i] * inv - sX[(qs * 64 + e * 16 + i) * 64 + lane];
        O[e][i] = o;
        ssq += o * o;
      }
    ssq += __shfl_xor(ssq, 32);
    const float rstd = rsqrtf(ssq * (1.f / 128.f) + EPS) * (1.f - lam_init);
    const float* sg = p.subln_g + L * 128;
#pragma unroll
    for (int e = 0; e < 4; ++e)
#pragma unroll
      for (int g = 0; g < 4; ++g) {
        int e0 = e * 32 + 8 * g + 4 * h;
        float4 gg = *(const float4*)(sg + e0);
        uint2 v = {pack2(O[e][4 * g + 0] * rstd * gg.x, O[e][4 * g + 1] * rstd * gg.y),
                   pack2(O[e][4 * g + 2] * rstd * gg.z, O[e][4 * g + 3] * rstd * gg.w)};
        *(uint2*)(sO + (qs * 32 + r) * 272 + e0 * 2) = v;
      }
  }
  __syncthreads();
  if (m == 0) {
#pragma unroll
    for (int j = 0; j < 8; ++j) {
      int c = lane + 64 * j, row = c >> 4, ch = c & 15;
      uint4 v = *(const uint4*)(sO + (qs * 32 + row) * 272 + ch * 16);
      *(uint4*)(mixin + (size_t)(qrow0 + qs * 32 + row) * 1024 + hh * 128 + ch * 8) = v;
    }
  }
  __syncthreads();
}

#pragma float_control(pop)
DI int ssd_rowbase(int b, int sc) { return (sc < 2) ? (TLAT + b * 256 + sc * 128) : (b * SEQ + (sc - 2) * 128); }

DI void chunk_scan(const float* dtb, int rowbase, int col, float A, int lane, float& d0, float& d1, float& a0, float& a1,
                   float& c0, float& c1, float& total) {
  d0 = dtb[(size_t)(rowbase + 2 * lane) * 16 + col];
  d1 = dtb[(size_t)(rowbase + 2 * lane + 1) * 16 + col];
  a0 = d0 * A;
  a1 = d1 * A;
  float s = a0 + a1;
#pragma unroll
  for (int off = 1; off < 64; off <<= 1) {
    float t = __shfl_up(s, off);
    if (lane >= off) s += t;
  }
  c1 = s;
  c0 = s - a1;
  total = __shfl(s, 63);
}

DI void ssd_s1_item(const Params& p, int L, int item, unsigned char* smem) {
  const int tid = tid_(), lane = tid & 63, w = tid >> 6, r = lane & 31, h = lane >> 5;
  const int g = item & 1, bs = item >> 1, sc = bs % 130, b = bs / 130;
  const int rowbase = ssd_rowbase(b, sc);
  const u16* xbcT = (const u16*)(p.ws + OFF_R5);
  const float* dtb = (const float*)(p.ws + OFF_DTB);
  u16* Sst = (u16*)(p.ws + OFF_R1);
  float* dac = (float*)(p.ws + OFF_DAC);
  unsigned char* sXT = smem;
  unsigned char* sBT = smem + 69632;
  float* sWt = (float*)(smem + 69632 + 34816);
#pragma unroll
  for (int j = 0; j < 8; ++j) {
    int c = tid + 512 * j, ch = c >> 4, t8 = c & 15;
    *(uint4*)(sXT + ch * 272 + t8 * 16) = *(const uint4*)(xbcT + (size_t)(g * 256 + ch) * TT + rowbase + t8 * 8);
  }
#pragma unroll
  for (int j = 0; j < 4; ++j) {
    int c = tid + 512 * j, ch = c >> 4, t8 = c & 15;
    *(uint4*)(sBT + ch * 272 + t8 * 16) = *(const uint4*)(xbcT + (size_t)(512 + g * 128 + ch) * TT + rowbase + t8 * 8);
  }
  const int hd = w >> 1, dir = w & 1, H = g * 4 + hd;
  {
    const float A = -expf(p.a_log[L * 16 + dir * 8 + H]);
    float d0, d1, a0, a1, c0, c1, total;
    chunk_scan(dtb, rowbase, dir * 8 + H, A, lane, d0, d1, a0, a1, c0, c1, total);
    float w0, w1;
    if (dir == 0) { w0 = d0 * __expf(total - c0); w1 = d1 * __expf(total - c1); }
    else { w0 = d0 * __expf(c0 - a0); w1 = d1 * __expf(c1 - a1); }
    sWt[w * 128 + 2 * lane] = w0;
    sWt[w * 128 + 2 * lane + 1] = w1;
    if (lane == 0) dac[((b * 2 + dir) * 130 + sc) * 8 + H] = __expf(total);
  }
  __syncthreads();
  f32x16 acc[2][4];
#pragma unroll
  for (int a = 0; a < 2; ++a)
#pragma unroll
    for (int n = 0; n < 4; ++n)
#pragma unroll
      for (int i = 0; i < 16; ++i) acc[a][n][i] = 0.f;
#pragma unroll 2
  for (int ks = 0; ks < 8; ++ks) {
    float4 wa = *(const float4*)(sWt + w * 128 + ks * 16 + h * 8), wb = *(const float4*)(sWt + w * 128 + ks * 16 + h * 8 + 4);
    bf16x8 af[2], bfr[4];
#pragma unroll
    for (int a = 0; a < 2; ++a) {
      uint4 u = *(const uint4*)(sXT + (hd * 64 + a * 32 + r) * 272 + ks * 32 + h * 16);
      af[a] = mk8(pack2(blo(u.x) * wa.x, bhi(u.x) * wa.y), pack2(blo(u.y) * wa.z, bhi(u.y) * wa.w),
                  pack2(blo(u.z) * wb.x, bhi(u.z) * wb.y), pack2(blo(u.w) * wb.z, bhi(u.w) * wb.w));
    }
#pragma unroll
    for (int n = 0; n < 4; ++n) bfr[n] = *(const bf16x8*)(sBT + (n * 32 + r) * 272 + ks * 32 + h * 16);
#pragma unroll
    for (int a = 0; a < 2; ++a)
#pragma unroll
      for (int n = 0; n < 4; ++n) acc[a][n] = MFMA32(af[a], bfr[n], acc[a][n]);
  }
  u16* dst = Sst + ((size_t)((b * 2 + dir) * 130 + sc) * 8 + H) * 8192;
#pragma unroll
  for (int a = 0; a < 2; ++a)
#pragma unroll
    for (int n = 0; n < 4; ++n)
#pragma unroll
      for (int i = 0; i < 16; ++i)
        dst[(a * 32 + crow(i, h)) * 128 + n * 32 + r] = (u16)(pack2(acc[a][n][i], 0.f) & 0xffffu);
  __syncthreads();
}

DI void ssd_s2_phase(const Params& p) {
  const u16* Sst = (const u16*)(p.ws + OFF_R1);
  u16* Hb = (u16*)(p.ws + OFF_HB);
  const float* dac = (const float*)(p.ws + OFF_DAC);
  const int nthreads = gridDim.x * 512;
  for (int gid = bid_() * 512 + threadIdx.x; gid < 131072; gid += nthreads) {
    const int bd = gid >> 15, e2 = gid & 32767, dir = bd & 1;
    const int head = e2 >> 12;
    float2 hc = make_float2(0.f, 0.f);
#pragma unroll 1
    for (int s0 = 0; s0 < 130; s0 += 10) {
      float2 tmp[10];
      float dd[10];
#pragma unroll
      for (int q = 0; q < 10; ++q) {
        int step = s0 + q;
        int sc = (dir == 0) ? step : (step < 2 ? 1 - step : 131 - step);
        {
          unsigned u_ = *(const unsigned*)(Sst + ((size_t)(bd * 130 + sc) * 8) * 8192 + 2 * e2);
          tmp[q] = make_float2(blo(u_), bhi(u_));
        }
        dd[q] = dac[(bd * 130 + sc) * 8 + head];
      }
#pragma unroll
      for (int q = 0; q < 10; ++q) {
        int step = s0 + q;
        int sc = (dir == 0) ? step : (step < 2 ? 1 - step : 131 - step);
        *(unsigned*)(Hb + ((size_t)(bd * 130 + sc) * 8) * 8192 + 2 * e2) = pack2(hc.x, hc.y);
        hc.x = hc.x * dd[q] + tmp[q].x;
        hc.y = hc.y * dd[q] + tmp[q].y;
      }
    }
  }
}

DI void ssd_s3_item(const Params& p, int L, int item, unsigned char* smem) {
  const int tid = tid_(), lane = tid & 63, w = tid >> 6, r = lane & 31, h = lane >> 5;
  const int g = item & 1, bs = item >> 1, sc = bs % 130, b = bs / 130;
  const int rowbase = ssd_rowbase(b, sc);
  const u16* xbcc = (const u16*)(p.ws + OFF_R0);
  const u16* xbcT = (const u16*)(p.ws + OFF_R5);
  const u16* zb = (const u16*)(p.ws + OFF_R2 + UB / 2);
  u16* ubuf = (u16*)(p.ws + OFF_R2);
  const float* dtb = (const float*)(p.ws + OFF_DTB);
  const u16* Hb = (const u16*)(p.ws + OFF_HB);
  unsigned char* sC = smem;
  unsigned char* sB = smem + 34816;
  unsigned char* sXT = smem + 69632;
  float* sCum = (float*)(smem + 139264);
  float* sDt = sCum + 1024;
#pragma unroll
  for (int j = 0; j < 4; ++j) {
    int c = tid + 512 * j, t = c >> 4, n8 = c & 15;
    *(uint4*)(sC + t * 272 + n8 * 16) = *(const uint4*)(xbcc + (size_t)(rowbase + t) * 1024 + 768 + g * 128 + n8 * 8);
    *(uint4*)(sB + t * 272 + n8 * 16) = *(const uint4*)(xbcc + (size_t)(rowbase + t) * 1024 + 512 + g * 128 + n8 * 8);
  }
#pragma unroll
  for (int j = 0; j < 8; ++j) {
    int c = tid + 512 * j, ch = c >> 4, t8 = c & 15;
    *(uint4*)(sXT + ch * 272 + t8 * 16) = *(const uint4*)(xbcT + (size_t)(g * 256 + ch) * TT + rowbase + t8 * 8);
  }
  {
    const int hd = w >> 1, dir = w & 1, H = g * 4 + hd;
    const float A = -expf(p.a_log[L * 16 + dir * 8 + H]);
    float d0, d1, a0, a1, c0, c1, total;
    chunk_scan(dtb, rowbase, dir * 8 + H, A, lane, d0, d1, a0, a1, c0, c1, total);
    float* cu = sCum + (dir * 4 + hd) * 128;
    float* dd = sDt + (dir * 4 + hd) * 128;
    if (dir == 0) { cu[2 * lane] = c0; cu[2 * lane + 1] = c1; }
    else { cu[2 * lane] = total - c0 + a0; cu[2 * lane + 1] = total - c1 + a1; }
    dd[2 * lane] = d0;
    dd[2 * lane + 1] = d1;
  }
  __syncthreads();
  {
    const int ti = w >> 1, tj0 = 2 * (w & 1);
    f32x16 cb[2];
#pragma unroll
    for (int q = 0; q < 2; ++q)
#pragma unroll
      for (int i = 0; i < 16; ++i) cb[q][i] = 0.f;
#pragma unroll
    for (int ks = 0; ks < 8; ++ks) {
      bf16x8 a = *(const bf16x8*)(sC + (ti * 32 + r) * 272 + ks * 32 + h * 16);
#pragma unroll
      for (int q = 0; q < 2; ++q) {
        bf16x8 bb = *(const bf16x8*)(sB + ((tj0 + q) * 32 + r) * 272 + ks * 32 + h * 16);
        cb[q] = MFMA32(a, bb, cb[q]);
      }
    }
    __syncthreads();
#pragma unroll
    for (int q = 0; q < 2; ++q)
#pragma unroll
      for (int i = 0; i < 16; ++i)
        *(u16*)(sB + (ti * 32 + crow(i, h)) * 272 + ((tj0 + q) * 32 + r) * 2) = (u16)(pack2(cb[q][i], 0.f) & 0xffffu);
    __syncthreads();
  }
  const int hd = w >> 1, th = w & 1, H = g * 4 + hd;
  const float* cuF = sCum + (0 * 4 + hd) * 128;
  const float* cuB = sCum + (1 * 4 + hd) * 128;
  const float* dtF = sDt + (0 * 4 + hd) * 128;
  const float* dtB = sDt + (1 * 4 + hd) * 128;
  f32x16 y[2][2];
#pragma unroll
  for (int dir = 0; dir < 2; ++dir) {
    f32x16 acc[2][2];
#pragma unroll
    for (int a = 0; a < 2; ++a)
#pragma unroll
      for (int n = 0; n < 2; ++n)
#pragma unroll
        for (int i = 0; i < 16; ++i) acc[a][n][i] = 0.f;
    const u16* hp = Hb + ((size_t)((b * 2 + dir) * 130 + sc) * 8 + H) * 8192 + r * 128 + h * 8;
    bf16x8 hf[8][2];
#pragma unroll
    for (int ks = 0; ks < 8; ++ks)
#pragma unroll
      for (int n = 0; n < 2; ++n) hf[ks][n] = *(const bf16x8*)(hp + n * 32 * 128 + ks * 16);
#pragma unroll
    for (int ks = 0; ks < 8; ++ks) {
      bf16x8 af[2];
#pragma unroll
      for (int a = 0; a < 2; ++a) af[a] = *(const bf16x8*)(sC + (th * 64 + a * 32 + r) * 272 + ks * 32 + h * 16);
#pragma unroll
      for (int a = 0; a < 2; ++a)
#pragma unroll
        for (int n = 0; n < 2; ++n) acc[a][n] = MFMA32(af[a], hf[ks][n], acc[a][n]);
    }
    const float* cu = (dir == 0) ? cuF : cuB;
#pragma unroll
    for (int a = 0; a < 2; ++a)
#pragma unroll
      for (int i = 0; i < 16; ++i) {
        float e = __expf(cu[th * 64 + a * 32 + crow(i, h)]);
#pragma unroll
        for (int n = 0; n < 2; ++n) {
          if (dir == 0) y[a][n][i] = acc[a][n][i] * e;
          else y[a][n][i] += acc[a][n][i] * e;
        }
      }
  }
#pragma unroll 1
  for (int ks = 0; ks < 8; ++ks) {
    const int s0 = ks * 16 + h * 8;
    float cFs[8], cBs[8], dFs[8], dBs[8];
    {
      float4 v0, v1;
      v0 = *(const float4*)(cuF + s0); v1 = *(const float4*)(cuF + s0 + 4);
      cFs[0] = v0.x; cFs[1] = v0.y; cFs[2] = v0.z; cFs[3] = v0.w; cFs[4] = v1.x; cFs[5] = v1.y; cFs[6] = v1.z; cFs[7] = v1.w;
      v0 = *(const float4*)(cuB + s0); v1 = *(const float4*)(cuB + s0 + 4);
      cBs[0] = v0.x; cBs[1] = v0.y; cBs[2] = v0.z; cBs[3] = v0.w; cBs[4] = v1.x; cBs[5] = v1.y; cBs[6] = v1.z; cBs[7] = v1.w;
      v0 = *(const float4*)(dtF + s0); v1 = *(const float4*)(dtF + s0 + 4);
      dFs[0] = v0.x; dFs[1] = v0.y; dFs[2] = v0.z; dFs[3] = v0.w; dFs[4] = v1.x; dFs[5] = v1.y; dFs[6] = v1.z; dFs[7] = v1.w;
      v0 = *(const float4*)(dtB + s0); v1 = *(const float4*)(dtB + s0 + 4);
      dBs[0] = v0.x; dBs[1] = v0.y; dBs[2] = v0.z; dBs[3] = v0.w; dBs[4] = v1.x; dBs[5] = v1.y; dBs[6] = v1.z; dBs[7] = v1.w;
    }
    bf16x8 af[2], bfr[2];
#pragma unroll
    for (int a = 0; a < 2; ++a) {
      const int t = th * 64 + a * 32 + r;
      const float cFt = cuF[t], cBt = cuB[t];
      uint4 u = *(const uint4*)(sB + t * 272 + s0 * 2);
      float cbv[8] = {blo(u.x), bhi(u.x), blo(u.y), bhi(u.y), blo(u.z), bhi(u.z), blo(u.w), bhi(u.w)};
      float gv[8];
#pragma unroll
      for (int j = 0; j < 8; ++j) {
        const int s = s0 + j;
        float mf = (s <= t) ? __expf(cFt - cFs[j]) * dFs[j] : 0.f;
        float mb = (s >= t) ? __expf(cBt - cBs[j]) * dBs[j] : 0.f;
        gv[j] = cbv[j] * (mf + mb);
      }
      af[a] = mk8(pack2(gv[0], gv[1]), pack2(gv[2], gv[3]), pack2(gv[4], gv[5]), pack2(gv[6], gv[7]));
    }
#pragma unroll
    for (int n = 0; n < 2; ++n) bfr[n] = *(const bf16x8*)(sXT + (hd * 64 + n * 32 + r) * 272 + ks * 32 + h * 16);
#pragma unroll
    for (int a = 0; a < 2; ++a)
#pragma unroll
      for (int n = 0; n < 2; ++n) y[a][n] = MFMA32(af[a], bfr[n], y[a][n]);
  }
  const float Dh = p.d_skip[L * 8 + H];
#pragma unroll
  for (int a = 0; a < 2; ++a)
#pragma unroll
    for (int n = 0; n < 2; ++n)
#pragma unroll
      for (int i = 0; i < 16; ++i) {
        const int t = th * 64 + a * 32 + crow(i, h), pp = n * 32 + r;
        float xv = bf2f(*(const u16*)(sXT + (hd * 64 + pp) * 272 + t * 2));
        float uv = y[a][n][i] + Dh * xv;
        ubuf[(size_t)(rowbase + t) * 512 + H * 64 + pp] = (u16)(pack2(uv, 0.f) & 0xffffu);
      }
  __syncthreads();
}

DI void gnorm_phase(const Params& p, int L) {
  const int tid = tid_(), lane = tid & 63, w = tid >> 6;
  const u16* ubuf = (const u16*)(p.ws + OFF_R2);
  const u16* zb = (const u16*)(p.ws + OFF_R2 + UB / 2);
  u16* mixin = (u16*)(p.ws + OFF_R4);
  const float* g = p.ssd_norm_g + L * 512 + lane * 8;
  const int nb = gridDim.x;
  const int nrows = (L == 1) ? TLAT : TT;
  for (int row = bid_() * 8 + w; row < nrows; row += nb * 8) {
    uint4 u = *(const uint4*)(ubuf + (size_t)row * 512 + lane * 8);
    uint4 zz = *(const uint4*)(zb + (size_t)row * 512 + lane * 8);
    float v[8] = {blo(u.x) * silu_f(blo(zz.x)), bhi(u.x) * silu_f(bhi(zz.x)), blo(u.y) * silu_f(blo(zz.y)),
                  bhi(u.y) * silu_f(bhi(zz.y)), blo(u.z) * silu_f(blo(zz.z)), bhi(u.z) * silu_f(bhi(zz.z)),
                  blo(u.w) * silu_f(blo(zz.w)), bhi(u.w) * silu_f(bhi(zz.w))};
    float ssq = 0.f;
#pragma unroll
    for (int e = 0; e < 8; ++e) ssq += v[e] * v[e];
    ssq = wave_sum(ssq);
    const float rstd = rsqrtf(ssq * (1.f / 512.f) + EPS);
    uint4 o = {pack2(v[0] * rstd * g[0], v[1] * rstd * g[1]), pack2(v[2] * rstd * g[2], v[3] * rstd * g[3]),
               pack2(v[4] * rstd * g[4], v[5] * rstd * g[5]), pack2(v[6] * rstd * g[6], v[7] * rstd * g[7])};
    *(uint4*)(mixin + (size_t)row * 1024 + 512 + lane * 8) = o;
  }
}

#define XB_TMO 128
#define XB_XCNT(j) (256 + 64 * (j))
#define XB_XSUB(j) (1280 + 64 * (j))
#define XB_XGEN(j) (2304 + 64 * (j))
#define XB_TOP 3328
#define XB_TOPGEN 3392
#define XCD_BAR_WORDS 3456
#define XB_SPIN_CAP (1u << 20)
#define LAS __attribute__((address_space(3)))
DI unsigned xb_ld(unsigned* p) { return __hip_atomic_load(p, __ATOMIC_RELAXED, __HIP_MEMORY_SCOPE_AGENT); }
DI unsigned xb_add(unsigned* p, unsigned v) { return __hip_atomic_fetch_add(p, v, __ATOMIC_RELAXED, __HIP_MEMORY_SCOPE_AGENT); }
DI unsigned xb_xcc_id() { return (unsigned)__builtin_amdgcn_s_getreg((3 << 11) | 20) & 0xFu; }
#define XB_SPIN(cond, bar)                                                                              \
  do {                                                                                                  \
    unsigned _sp = 0;                                                                                   \
    while (cond) {                                                                                      \
      __builtin_amdgcn_s_sleep(1);                                                                      \
      if ((++_sp & 255u) == 0u) {                                                                       \
        if (xb_ld(&(bar)[XB_TMO])) break;                                                               \
        if (_sp > XB_SPIN_CAP) { atomicAdd(&(bar)[XB_TMO], 1u); break; }                                \
      }                                                                                                 \
    }                                                                                                   \
  } while (0)
struct XcdBarrier {
  unsigned* bar;
  unsigned x;
  volatile LAS unsigned* st;
};
DI XcdBarrier xcd_barrier_post(unsigned* bar, volatile LAS unsigned* st) {
  XcdBarrier b;
  b.bar = bar;
  b.x = xb_xcc_id();
  b.st = st;
  if (threadIdx.x == 0) (void)xb_add(&bar[XB_XCNT(b.x)], 1u);
  return b;
}
DI void xcd_barrier_complete(unsigned* bar, unsigned x, unsigned& nloc, unsigned& nx) {
  const unsigned G = gridDim.x * gridDim.y * gridDim.z;
  unsigned sum, cnt, mine, sp = 0u;
  for (;;) {
    sum = 0u; cnt = 0u; mine = 0u;
#pragma unroll
    for (unsigned j = 0; j < 16; ++j) {
      const unsigned c = xb_ld(&bar[XB_XCNT(j)]);
      sum += c;
      cnt += (c > 0u) ? 1u : 0u;
      mine = (j == x) ? c : mine;
    }
    if (sum == G) break;
    __builtin_amdgcn_s_sleep(1);
    if ((++sp & 255u) == 0u) {
      if (xb_ld(&bar[XB_TMO])) break;
      if (sp > XB_SPIN_CAP) { atomicAdd(&bar[XB_TMO], 1u); break; }
    }
  }
  nloc = mine > 0u ? mine : 1u;
  nx = cnt > 0u ? cnt : 1u;
}
DI void xcd_barrier(const XcdBarrier& b) {
  asm volatile("s_waitcnt vmcnt(0)" ::: "memory");
  __syncthreads();
  if (threadIdx.x == 0) {
    unsigned* bar = b.bar;
    __builtin_amdgcn_s_waitcnt(0);
    unsigned nloc = b.st[0], nx = b.st[1];
    if (nloc == 0u) { xcd_barrier_complete(bar, b.x, nloc, nx); b.st[0] = nloc; b.st[1] = nx; }
    const unsigned old = xb_add(&bar[XB_XSUB(b.x)], 1u);
    const unsigned gen = old / nloc;
    if (old + 1u == (gen + 1u) * nloc) {
      __builtin_amdgcn_fence(__ATOMIC_RELEASE, "agent");
      asm volatile("s_waitcnt vmcnt(0)" ::: "memory");
      const unsigned og = xb_add(&bar[XB_TOP], 1u);
      const unsigned tg = og / nx;
      if (og + 1u == (tg + 1u) * nx) xb_add(&bar[XB_TOPGEN], 1u);
      else XB_SPIN(xb_ld(&bar[XB_TOPGEN]) == tg, bar);
      __builtin_amdgcn_fence(__ATOMIC_ACQUIRE, "agent");
      xb_add(&bar[XB_XGEN(b.x)], 1u);
      asm volatile("s_waitcnt vmcnt(0)" ::: "memory");
    } else {
      XB_SPIN(xb_ld(&bar[XB_XGEN(b.x)]) == gen, bar);
      __builtin_amdgcn_fence(__ATOMIC_ACQUIRE, "agent");
      asm volatile("s_waitcnt vmcnt(0)" ::: "memory");
    }
  }
  __syncthreads();
}

constexpr int NPHASE = 2 + 11 * 2;

template <int s>
DI void layer_phase(const Params& p, int L, unsigned char* smem) {
  const int nb = gridDim.x, vb = vblock();
  EpiArgs ea;
  ea.dst = nullptr; ea.ldd = 0;
  ea.qk = (u16*)(p.ws + OFF_R1); ea.vT = (u16*)(p.ws + OFF_R2); ea.zb = (u16*)(p.ws + OFF_R2 + UB / 2);
  ea.xraw = (u16*)(p.ws + OFF_R3); ea.rope = (const float2*)(p.ws + OFF_ROPE);
  switch (s) {
    case 0:
      gemm_phase<EPI_INPROJ, 4>((const u16*)(p.ws + OFF_R0), 1024, (const u16*)(p.ws + OFF_WIN) + (size_t)L * 3072 * 1024, 1024,
                                1024, 12, 128, 0, ea, smem);
      gemm_phase<EPI_INPROJ, 1>((const u16*)(p.ws + OFF_R0), 1024, (const u16*)(p.ws + OFF_WIN) + (size_t)L * 3072 * 1024, 1024,
                                1024, 12, 8, TLAT, ea, smem);
      break;
    case 1:
      for (int it = vb; it < 1040; it += nb) conv_item(p, L, it, smem);
      for (int u = vb; u < 1024; u += nb) attn_unit(p, L, u, smem);
      if (L == 0 && vb >= 16 && vb < 32) attn_unit(p, L, 1024 + vb - 16, smem);
      break;
    case 2:
      for (int it = vb; it < 520; it += nb) ssd_s1_item(p, L, it, smem);
      break;
    case 3:
      ssd_s2_phase(p);
      break;
    case 4:
      if (L == 1) {
        for (int it = vb; it < 512; it += nb) {
          const int q = it >> 1;
          ssd_s3_item(p, L, (((q >> 7) * 130 + 2 + (q & 127)) << 1) | (it & 1), smem);
        }
      } else {
        for (int it = vb; it < 520; it += nb) ssd_s3_item(p, L, it, smem);
      }
      break;
    case 5:
      gnorm_phase(p, L);
      break;
    case 6:
      ea.dst = (u16*)(p.ws + OFF_R1); ea.ldd = 1024;
      gemm_phase<EPI_PLAIN, 4>((const u16*)(p.ws + OFF_R4), 1024, (const u16*)(p.ws + OFF_WOUT) + (size_t)L * 1024 * 1024, 1024,
                               1024, 4, 128, 0, ea, smem);
      if (L == 0)
        gemm_phase<EPI_PLAIN, 1>((const u16*)(p.ws + OFF_R4), 1024, (const u16*)(p.ws + OFF_WOUT) + (size_t)L * 1024 * 1024,
                                 1024, 1024, 4, 8, TLAT, ea, smem);
      break;
    case 7:
      norm_phase<1>(p, L, smem);
      break;
    case 8:
      ea.dst = (u16*)(p.ws + OFF_R3); ea.ldd = DFF;
      gemm_phase<EPI_FFNIN, 4>((const u16*)(p.ws + OFF_R0), 1024, (const u16*)(p.ws + OFF_WFI) + (size_t)L * 5632 * 1024, 1024,
                               1024, 22, 128, 0, ea, smem);
      if (L == 0)
        gemm_phase<EPI_FFNIN, 1>((const u16*)(p.ws + OFF_R0), 1024, (const u16*)(p.ws + OFF_WFI) + (size_t)L * 5632 * 1024,
                                 1024, 1024, 22, 8, TLAT, ea, smem);
      break;
    case 9:
      ea.dst = (u16*)(p.ws + OFF_R1); ea.ldd = 1024;
      gemm_phase<EPI_PLAIN, 4>((const u16*)(p.ws + OFF_R3), DFF, (const u16*)(p.ws + OFF_WFO) + (size_t)L * 1024 * DFF, DFF, DFF,
                               4, 128, 0, ea, smem);
      if (L == 0)
        gemm_phase<EPI_PLAIN, 1>((const u16*)(p.ws + OFF_R3), DFF, (const u16*)(p.ws + OFF_WFO) + (size_t)L * 1024 * DFF, DFF,
                                 DFF, 4, 8, TLAT, ea, smem);
      break;
    case 10:
      norm_phase<2>(p, L, smem);
      break;
  }
}

DI void run_phase(const Params& p, int ph, unsigned char* smem) {
  if (ph == 0) { prologue_phase(p, smem); return; }
  if (ph == 1) { norm_phase<0>(p, 0, smem); return; }
  const int L = (ph - 2) / 11, s = (ph - 2) % 11;
  switch (s) {
    case 0: layer_phase<0>(p, L, smem); break;
    case 1: layer_phase<1>(p, L, smem); break;
    case 2: layer_phase<2>(p, L, smem); break;
    case 3: layer_phase<3>(p, L, smem); break;
    case 4: layer_phase<4>(p, L, smem); break;
    case 5: layer_phase<5>(p, L, smem); break;
    case 6: layer_phase<6>(p, L, smem); break;
    case 7: layer_phase<7>(p, L, smem); break;
    case 8: layer_phase<8>(p, L, smem); break;
    case 9: layer_phase<9>(p, L, smem); break;
    case 10: layer_phase<10>(p, L, smem); break;
  }
}

#ifdef PHASE_TEST
template <int PH>
__global__ void __launch_bounds__(512) tk(Params p, int L) {
  __shared__ __attribute__((aligned(16))) unsigned char smem[SMEM_BYTES];
  if (PH == 0) prologue_phase(p, smem);
  else if (PH == 1) norm_phase<0>(p, 0, smem);
  else layer_phase<(PH >= 2 ? PH - 2 : 0)>(p, L, smem);
}
template __global__ void tk<0>(Params, int);
template __global__ void tk<1>(Params, int);
template __global__ void tk<2>(Params, int);
template __global__ void tk<3>(Params, int);
template __global__ void tk<4>(Params, int);
template __global__ void tk<5>(Params, int);
template __global__ void tk<6>(Params, int);
template __global__ void tk<7>(Params, int);
template __global__ void tk<8>(Params, int);
template __global__ void tk<9>(Params, int);
template __global__ void tk<10>(Params, int);
template __global__ void tk<11>(Params, int);
template __global__ void tk<12>(Params, int);
#endif

#if MULTI_LAUNCH
__global__ void __launch_bounds__(512) phase_kernel(Params p, int ph) {
  __shared__ __attribute__((aligned(16))) unsigned char smem[SMEM_BYTES];
  run_phase(p, ph, smem);
}
#else
__global__ void __launch_bounds__(512) mega_kernel(Params p) {
  __shared__ __attribute__((aligned(16))) unsigned char smem[SMEM_BYTES];
  cg::grid_group grid = cg::this_grid();
  __shared__ uint4 xb_words;
  unsigned* bar = (unsigned*)(p.ws + WS_END + 256);
  if (threadIdx.x == 0) xb_words = make_uint4(0u, 0u, 0u, 0u);
  if (blockIdx.x == 0)
    for (int i = threadIdx.x; i < XCD_BAR_WORDS; i += 512) bar[i] = 0u;
  prologue_phase(p, smem);
  grid.sync();
  const XcdBarrier xb = xcd_barrier_post(bar, (volatile LAS unsigned*)&xb_words);
  norm_phase<0>(p, 0, smem);
  xcd_barrier(xb);
  {
    int L = 0;
    asm volatile("" : "+s"(L));
    layer_phase<0>(p, L, smem); xcd_barrier(xb);
    layer_phase<1>(p, L, smem); xcd_barrier(xb);
    layer_phase<2>(p, L, smem); xcd_barrier(xb);
    layer_phase<3>(p, L, smem); xcd_barrier(xb);
    layer_phase<4>(p, L, smem); xcd_barrier(xb);
    layer_phase<5>(p, L, smem); xcd_barrier(xb);
    layer_phase<6>(p, L, smem); xcd_barrier(xb);
    layer_phase<7>(p, L, smem); xcd_barrier(xb);
    layer_phase<8>(p, L, smem); xcd_barrier(xb);
    layer_phase<9>(p, L, smem); xcd_barrier(xb);
    layer_phase<10>(p, L, smem); xcd_barrier(xb);
  }
  {
    int L = 1;
    asm volatile("" : "+s"(L));
    layer_phase<0>(p, L, smem); xcd_barrier(xb);
    layer_phase<1>(p, L, smem); xcd_barrier(xb);
    layer_phase<2>(p, L, smem); xcd_barrier(xb);
    layer_phase<3>(p, L, smem); xcd_barrier(xb);
    layer_phase<4>(p, L, smem); xcd_barrier(xb);
    layer_phase<5>(p, L, smem); xcd_barrier(xb);
    layer_phase<6>(p, L, smem); xcd_barrier(xb);
    layer_phase<7>(p, L, smem); xcd_barrier(xb);
    layer_phase<8>(p, L, smem); xcd_barrier(xb);
    layer_phase<9>(p, L, smem); xcd_barrier(xb);
    layer_phase<10>(p, L, smem);
  }
}
#endif

extern "C" void kernel_launch(void* const* d_in, const int* in_sizes, int n_in, void* d_out, int out_size, void* d_ws,
                              size_t ws_size, hipStream_t stream) {
  if (n_in != 19 || ws_size < WS_END + 256 + XCD_BAR_WORDS * 4) {
    fprintf(stderr, "kernel_launch: unexpected n_in %d or ws_size %zu (< %zu)\n", n_in, ws_size, (size_t)WS_END);
    return;
  }
  Params p{};
  const float** pp = (const float**)&p;
  for (int i = 0; i < 19; ++i) pp[i] = (const float*)d_in[i];
  p.out = (float*)d_out;
  p.ws = (unsigned char*)d_ws;
#if MULTI_LAUNCH
  for (int ph = 0; ph < NPHASE; ++ph) hipLaunchKernelGGL(phase_kernel, dim3(256), dim3(512), 0, stream, p, ph);
#else
  static int grid_blocks = 0;
  if (!grid_blocks) {
    int dev = 0, cus = 0, per_cu = 0;
    hipGetDevice(&dev);
    hipDeviceGetAttribute(&cus, hipDeviceAttributeMultiprocessorCount, dev);
    hipOccupancyMaxActiveBlocksPerMultiprocessor(&per_cu, (const void*)mega_kernel, 512, 0);
    if (per_cu < 1) { fprintf(stderr, "kernel_launch: occupancy query says %d blocks/CU\n", per_cu); per_cu = 1; }
    grid_blocks = cus;
  }
  void* args[] = {&p};
  hipError_t e = hipLaunchCooperativeKernel((const void*)mega_kernel, dim3(grid_blocks), dim3(512), args, 0, stream);
  if (e != hipSuccess) fprintf(stderr, "cooperative launch failed: %s (grid %d)\n", hipGetErrorString(e), grid_blocks);
#endif
}
```
